# Optimizing an MI355X kernel written in HIP

```python
import math
import jax, jax.numpy as jnp
from jax import lax
import numpy as np

D_MODEL = 1024
BATCH = 8
SEQ = 4096
DEPTH = 2

EXPAND = 2
D_MIX = EXPAND * D_MODEL
N_GROUPS = 4
GROUP_W = D_MIX // N_GROUPS
HEAD_DIM = 64
H_A = GROUP_W // (2 * HEAD_DIM)
DV_A = 2 * HEAD_DIM
H_B = GROUP_W // HEAD_DIM
H_C = GROUP_W // HEAD_DIM
H_D = GROUP_W // HEAD_DIM
RWKV_DECAY_RANK = 32
RWKV_ICLR_RANK = 32
RWKV_SHIFT_W = 3 * GROUP_W + RWKV_DECAY_RANK + RWKV_ICLR_RANK
NUM_BUCKETS = 32
MAX_DISTANCE = 128
Q_BLOCK = 128
NORM_EPS = 1e-6
RWKV_LN_EPS = 64e-5
NEG_INF = -1e30
IN_WIDTHS = (GROUP_W, GROUP_W, GROUP_W, GROUP_W,
             GROUP_W, GROUP_W, GROUP_W, GROUP_W,
             GROUP_W, GROUP_W, GROUP_W, GROUP_W, H_C,
             RWKV_SHIFT_W, GROUP_W)
N_IN = sum(IN_WIDTHS)

kernel_name = "hymba_style_diff_sb_fox_rwkv7_hybrid"


def _split(a, widths):
    outs, off = [], 0
    for w in widths:
        outs.append(a[..., off:off + w])
        off += w
    return outs


def rms_norm(x, gain, eps=NORM_EPS):
    xf = x.astype(jnp.float32)
    y = xf * lax.rsqrt(jnp.mean(xf * xf, axis=-1, keepdims=True) + eps)
    return (y * gain.astype(jnp.float32)).astype(x.dtype)


def t5_causal_bucket(dist):
    max_exact = NUM_BUCKETS // 2
    d = jnp.maximum(dist, 1).astype(jnp.float32)
    large = max_exact + (jnp.log(d / max_exact) / math.log(MAX_DISTANCE / max_exact)
                         * (NUM_BUCKETS - max_exact)).astype(jnp.int32)
    large = jnp.minimum(large, NUM_BUCKETS - 1)
    return jnp.where(dist < max_exact, dist, large)


def _blocks(a):
    b, h, s = a.shape[:3]
    a = a.reshape((b, h, s // Q_BLOCK, Q_BLOCK) + a.shape[3:])
    return jnp.moveaxis(a, 2, 0)


def _unblocks(o):
    nb, b, h, qb, dv = o.shape
    return jnp.moveaxis(o, 0, 2).reshape(b, h, nb * qb, dv)


def differential_attention(q, k, v, bias_by_dist, lam):
    seq = q.shape[2]
    pos = jnp.arange(seq)
    scale = q.shape[-1] ** -0.5

    def block(args):
        qb, tb = args
        dist = tb[:, None] - pos[None, :]
        bias = jnp.transpose(bias_by_dist[jnp.clip(dist, 0, seq - 1)], (2, 0, 1)).astype(jnp.float32)
        s = jnp.einsum('bhqcd,bhkcd->bhcqk', qb, k).astype(jnp.float32) * scale + bias[None, :, None]
        s = jnp.where(dist >= 0, s, NEG_INF)
        p = jax.nn.softmax(s, axis=-1)
        w = p[:, :, 0] - lam * p[:, :, 1]
        return jnp.einsum('bhqk,bhkd->bhqd', w.astype(v.dtype), v)

    return _unblocks(lax.map(block, (_blocks(q), pos.reshape(-1, Q_BLOCK))))


def stick_breaking_attention(q, k, v):
    seq = q.shape[2]
    pos = jnp.arange(seq)
    scale = q.shape[-1] ** -0.5

    def block(args):
        qb, tb = args
        z = jnp.einsum('bhqd,bhkd->bhqk', qb, k).astype(jnp.float32) * scale
        causal = tb[:, None] > pos[None, :]
        log_beta = jax.nn.log_sigmoid(z)
        log_1mb = jnp.where(causal, log_beta - z, 0.0)
        after = lax.cumsum(log_1mb, axis=z.ndim - 1, reverse=True) - log_1mb
        a = jnp.where(causal, jnp.exp(log_beta + after), 0.0)
        return jnp.einsum('bhqk,bhkd->bhqd', a.astype(v.dtype), v)

    return _unblocks(lax.map(block, (_blocks(q), pos.reshape(-1, Q_BLOCK))))


def forgetting_attention(q, k, v, log_f):
    seq = q.shape[2]
    pos = jnp.arange(seq)
    scale = q.shape[-1] ** -0.5
    cum_f = jnp.cumsum(log_f, axis=-1)

    def block(args):
        qb, fb, tb = args
        s = jnp.einsum('bhqd,bhkd->bhqk', qb, k).astype(jnp.float32) * scale
        s = s + (fb[..., :, None] - cum_f[..., None, :])
        s = jnp.where(tb[:, None] >= pos[None, :], s, NEG_INF)
        p = jax.nn.softmax(s, axis=-1)
        return jnp.einsum('bhqk,bhkd->bhqd', p.astype(v.dtype), v)

    return _unblocks(lax.map(block, (_blocks(q), _blocks(cum_f), pos.reshape(-1, Q_BLOCK))))


def rwkv7_scan(r, decay, k, v, kk, b):
    bsz, _, h, n = r.shape

    def step(state, inp):
        r_t, w_t, k_t, v_t, kk_t, b_t = inp
        sa = jnp.einsum('bhij,bhj->bhi', state, -kk_t)
        state = (state * w_t[:, :, None, :] + sa[..., None] * b_t[:, :, None, :]
                 + v_t[..., None] * k_t[:, :, None, :])
        return state, jnp.einsum('bhij,bhj->bhi', state, r_t)

    xs = tuple(jnp.moveaxis(u, 1, 0) for u in (r, decay, k, v, kk, b))
    _, y = lax.scan(step, jnp.zeros((bsz, h, n, n), jnp.float32), xs)
    return jnp.moveaxis(y, 0, 1)


def rwkv7_branch(u, mu, w_up, w0, a_up, a0, kkr, ln_gain, ln_bias):
    bsz, seq, _ = u.shape
    f32 = jnp.float32
    u_prev = jnp.pad(u, ((0, 0), (1, 0), (0, 0)))[:, :seq]
    u = u + (u_prev - u) * mu
    r, k, v, w_lo, a_lo = _split(u, (GROUP_W, GROUP_W, GROUP_W, RWKV_DECAY_RANK, RWKV_ICLR_RANK))
    w_log = -jax.nn.softplus(-(w0 + jnp.tanh(w_lo) @ w_up).astype(f32)) - 0.5
    decay = jnp.exp(-jnp.exp(w_log))
    a = jax.nn.sigmoid((a0 + a_lo @ a_up).astype(f32))
    k_k, k_a, r_k = kkr[0].astype(f32), kkr[1].astype(f32), kkr[2].astype(f32)
    r, k, v = r.astype(f32), k.astype(f32), v.astype(f32)
    heads = lambda t: t.reshape(bsz, seq, H_D, HEAD_DIM)
    kk = heads(k * k_k)
    kk = kk / jnp.maximum(jnp.sqrt(jnp.sum(kk * kk, axis=-1, keepdims=True)), 1e-12)
    k = k * (1.0 + (a - 1.0) * k_a)
    rh, kh, vh, ah = heads(r), heads(k), heads(v), heads(a)
    y = rwkv7_scan(rh, heads(decay), kh, vh, kk, kk * ah)
    mean = jnp.mean(y, axis=-1, keepdims=True)
    var = jnp.mean(jnp.square(y - mean), axis=-1, keepdims=True)
    y = ((y - mean) * lax.rsqrt(var + RWKV_LN_EPS) * ln_gain.astype(f32).reshape(H_D, HEAD_DIM)
         + ln_bias.astype(f32).reshape(H_D, HEAD_DIM))
    y = y + jnp.sum(rh * kh * r_k.reshape(H_D, HEAD_DIM), axis=-1, keepdims=True) * vh
    return y.reshape(bsz, seq, GROUP_W).astype(u.dtype)


def setup_inputs(seed: int = 0) -> dict:
    key = jax.random.key(seed)
    ks = jax.random.split(key, 17)
    f32 = jnp.float32
    nrm = lambda k_, shape: jax.random.normal(k_, shape, f32)
    decay_ramp = jnp.tile(jnp.linspace(-6.0, -1.0, HEAD_DIM, dtype=f32), H_D)
    return {
        "x": nrm(ks[0], (BATCH, SEQ, D_MODEL)),
        "norm_gain": 1.0 + 0.02 * nrm(ks[1], (DEPTH, D_MODEL)),
        "w_in": nrm(ks[2], (DEPTH, D_MODEL, N_IN)) * D_MODEL ** -0.5,
        "w_out": nrm(ks[3], (DEPTH, D_MIX, D_MODEL)) * D_MIX ** -0.5,
        "rel_bias": 0.1 * nrm(ks[4], (NUM_BUCKETS, H_A)),
        "qk_gain": 1.0 + 0.02 * nrm(ks[5], (DEPTH, 4, HEAD_DIM)),
        "diff_lambda": 0.1 * nrm(ks[6], (DEPTH, 4, HEAD_DIM)),
        "forget_bias": 3.0 + 0.5 * nrm(ks[7], (DEPTH, H_C)),
        "out_gain": 1.0 + 0.02 * nrm(ks[8], (DEPTH, D_MIX)),
        "rwkv_mu": jax.random.uniform(ks[9], (DEPTH, RWKV_SHIFT_W), f32),
        "rwkv_w_up": 0.5 * nrm(ks[10], (DEPTH, RWKV_DECAY_RANK, GROUP_W)) * RWKV_DECAY_RANK ** -0.5,
        "rwkv_w0": decay_ramp[None, :] + 0.1 * nrm(ks[11], (DEPTH, GROUP_W)),
        "rwkv_a_up": 0.5 * nrm(ks[12], (DEPTH, RWKV_ICLR_RANK, GROUP_W)) * RWKV_ICLR_RANK ** -0.5,
        "rwkv_a0": 0.1 * nrm(ks[13], (DEPTH, GROUP_W)),
        "rwkv_kkr": jnp.array([0.85, 1.0, -0.04], f32)[None, :, None] + 0.02 * nrm(ks[14], (DEPTH, 3, GROUP_W)),
        "rwkv_ln_gain": 1.0 + 0.02 * nrm(ks[15], (DEPTH, GROUP_W)),
        "rwkv_ln_bias": 0.02 * nrm(ks[16], (DEPTH, GROUP_W)),
    }


def reference(x, norm_gain, w_in, w_out, rel_bias, qk_gain, diff_lambda, forget_bias, out_gain,
              rwkv_mu, rwkv_w_up, rwkv_w0, rwkv_a_up, rwkv_a0, rwkv_kkr, rwkv_ln_gain, rwkv_ln_bias):
    bsz, seq, _ = x.shape
    f32 = jnp.float32
    bias_by_dist = rel_bias[t5_causal_bucket(jnp.arange(seq))]
    to_heads = lambda t, h, d: t.reshape(bsz, seq, h, d).transpose(0, 2, 1, 3)
    from_heads = lambda t: t.transpose(0, 2, 1, 3)
    h_res = x
    for l in range(DEPTH):
        h = rms_norm(h_res, norm_gain[l])
        proj = h @ w_in[l]
        (aq, ak, av, ag, bq, bk, bv, bg, cq, ck, cv, cg, cf, d_in, dg) = _split(proj, IN_WIDTHS)

        qa = rms_norm(aq.reshape(bsz, seq, H_A, 2, HEAD_DIM), qk_gain[l, 0]).transpose(0, 2, 1, 3, 4)
        ka = rms_norm(ak.reshape(bsz, seq, H_A, 2, HEAD_DIM), qk_gain[l, 1]).transpose(0, 2, 1, 3, 4)
        va = to_heads(av, H_A, DV_A)
        lam_init = 0.8 - 0.6 * math.exp(-0.3 * l)
        dl = diff_lambda[l].astype(f32)
        lam = jnp.exp(jnp.sum(dl[0] * dl[1])) - jnp.exp(jnp.sum(dl[2] * dl[3])) + lam_init
        oa = from_heads(differential_attention(qa, ka, va, bias_by_dist, lam))
        oa = rms_norm(oa, out_gain[l, :GROUP_W].reshape(H_A, DV_A)) * (1.0 - lam_init)
        oa = oa.reshape(bsz, seq, GROUP_W)

        ob = from_heads(stick_breaking_attention(to_heads(bq, H_B, HEAD_DIM), to_heads(bk, H_B, HEAD_DIM),
                                                 to_heads(bv, H_B, HEAD_DIM)))
        ob = rms_norm(ob, out_gain[l, GROUP_W:2 * GROUP_W].reshape(H_B, HEAD_DIM)).reshape(bsz, seq, GROUP_W)

        qc = from_heads(rms_norm(cq.reshape(bsz, seq, H_C, HEAD_DIM), qk_gain[l, 2]))
        kc = from_heads(rms_norm(ck.reshape(bsz, seq, H_C, HEAD_DIM), qk_gain[l, 3]))
        log_f = jax.nn.log_sigmoid((cf + forget_bias[l]).astype(f32)).transpose(0, 2, 1)
        oc = from_heads(forgetting_attention(qc, kc, to_heads(cv, H_C, HEAD_DIM), log_f))
        oc = rms_norm(oc, out_gain[l, 2 * GROUP_W:3 * GROUP_W].reshape(H_C, HEAD_DIM)).reshape(bsz, seq, GROUP_W)

        od = rwkv7_branch(d_in, rwkv_mu[l], rwkv_w_up[l], rwkv_w0[l], rwkv_a_up[l], rwkv_a0[l],
                          rwkv_kkr[l], rwkv_ln_gain[l] * out_gain[l, 3 * GROUP_W:], rwkv_ln_bias[l])

        mixed = jnp.concatenate([oa * jax.nn.silu(ag), ob * jax.nn.silu(bg),
                                 oc * jax.nn.silu(cg), od * jax.nn.silu(dg)], axis=-1)
        h_res = h_res + mixed @ w_out[l]
    return h_res
```

```cpp
#include <hip/hip_runtime.h>
#include <hip/hip_cooperative_groups.h>
#include <cstdio>
#include <cstdint>
namespace cg = cooperative_groups;

#ifndef MK_PER_PHASE
#define MK_PER_PHASE 0
#endif

#ifndef REP1A
#define REP1A 1
#endif
#ifndef REP2A
#define REP2A 1
#endif
#ifndef REP2B
#define REP2B 1
#endif
namespace pg8 {
#define PG8_LAS __attribute__((address_space(3)))
typedef unsigned short bf16_t;
typedef short bf16x8 __attribute__((ext_vector_type(8)));
typedef float f32x4 __attribute__((ext_vector_type(4)));
typedef unsigned u32x4 __attribute__((ext_vector_type(4)));
constexpr int BM = 256, BK = 64, HALF = 128, HTB = HALF * BK * 2  , STAGE_BYTES = 8 * HTB, NXCD = 8, WGM = 8;

__host__ __device__ __forceinline__ int lds_byte(int r, int c) { const int st = (r >> 4) * 2 + (c >> 5), rr = r & 15, cc = c & 31, ob = rr * 64 + cc * 2; return st * 1024 + (ob ^ (((ob >> 9) & 1) << 5)); }
__host__ __device__ __forceinline__ void stage_rc(int b, int& R, int& C) { const int st = b / 1024, sb = b % 1024, swz = sb ^ (((sb >> 9) & 1) << 5); R = (st >> 1) * 16 + swz / 64; C = (st & 1) * 32 + (swz % 64) / 2; }
__host__ __device__ __forceinline__ int perm32(int rho) { const int n = rho >> 4, i = rho & 15; return 8 * (i >> 2) + 4 * n + (i & 3); }

struct Unit { int pm, pn; };
struct Gemm { const bf16_t* A; const bf16_t* Bt; int M, N, K; };

struct StaticOrder {
    int nM, nN, nwg, G, c;
    __host__ __device__ void init(int M, int N, int G_, int c_) { nM = M / BM; nN = N / BM; nwg = nM * nN; G = G_; c = c_; }
    __host__ __device__ bool next(int i, Unit& u) const {
        const long L = (long)i * G + c; if (L >= nwg) return false;
        int wgid = (int)L; { const int q = nwg / NXCD, r = nwg % NXCD, xcd = wgid % NXCD, off = wgid / NXCD; wgid = (xcd < r ? xcd * (q + 1) : r * (q + 1) + (xcd - r) * q) + off; }
        const int nig = WGM * nN, gid = wgid / nig, fm = gid * WGM, gsz = (nM - fm) < WGM ? (nM - fm) : WGM;
        u.pm = fm + ((wgid % nig) % gsz); u.pn = (wgid % nig) / gsz; return true;
    }
    __device__ __forceinline__ void a_ready(const Unit&) const {}
    __device__ __forceinline__ void done(const Unit&) const {}
};

__device__ __forceinline__ unsigned cvt_pk_bf16(float lo, float hi) { unsigned r; asm volatile("v_cvt_pk_bf16_f32 %0, %1, %2" : "=v"(r) : "v"(lo), "v"(hi)); return r; }
typedef float f32x2 __attribute__((ext_vector_type(2)));

typedef unsigned u32x2 __attribute__((ext_vector_type(2)));
struct EpiIn {
    static constexpr bool PERM = true, AFTER_DRAIN = false;
    bf16_t* P; float* misc; const float* hss; int ntile_main;
    __device__ __forceinline__ void operator()(const f32x4 (&acc)[2][2][4][2], const Unit& u, int wr, int wc, int fr, int fq) const {
        const int row0 = u.pm * BM + wr * 64 + fr;
        float rsv[2][4];
#pragma unroll
        for (int ai = 0; ai < 2; ++ai) {
#pragma unroll
            for (int m = 0; m < 4; ++m) {
                const int row = row0 + ai * HALF + m * 16;
                const f32x4 h0 = *((const f32x4*)(hss + (size_t)row * 16) + fq);
                float ss = (h0[0] + h0[1]) + (h0[2] + h0[3]);
                ss += __shfl_xor(ss, 16); ss += __shfl_xor(ss, 32);
                rsv[ai][m] = 1.0f / sqrtf(ss * (1.0f / 1024.0f) + 1e-6f);
            }
            asm volatile("" ::: "memory");
        }
#pragma unroll
        for (int ai = 0; ai < 2; ++ai)
#pragma unroll
            for (int m = 0; m < 4; ++m) {
                const int row = row0 + ai * HALF + m * 16;
                const float rs = rsv[ai][m];
                if (u.pn < ntile_main) {
                    bf16_t* rowp = P + (size_t)row * 4160 + u.pn * BM + wc * 32 + 8 * fq;
#pragma unroll
                    for (int bj = 0; bj < 2; ++bj) {
                        const f32x4 v0 = acc[ai][bj][m][0] * rs, v1 = acc[ai][bj][m][1] * rs;
                        u32x4 w; w.x = cvt_pk_bf16(v0[0], v0[1]); w.y = cvt_pk_bf16(v0[2], v0[3]); w.z = cvt_pk_bf16(v1[0], v1[1]); w.w = cvt_pk_bf16(v1[2], v1[3]);
                        *(u32x4*)(rowp + bj * HALF) = w;
                    }
                } else {
                    const int c0 = wc * 32 + 8 * fq;
                    if (c0 < 72) {
                        *(f32x4*)(misc + (size_t)row * 80 + c0) = acc[ai][0][m][0] * rs;
                        *(f32x4*)(misc + (size_t)row * 80 + c0 + 4) = acc[ai][0][m][1] * rs;
                    }
                }
                asm volatile("" ::: "memory");
            }
    }
};
struct EpiOut {
    static constexpr bool PERM = false, AFTER_DRAIN = false;
    const float* res; float* out; bf16_t* hb; float* hss; int write_hb;
    __device__ __forceinline__ void operator()(const f32x4 (&acc)[2][2][4][2], const Unit& u, int wr, int wc, int fr, int fq) const {
        const int col0 = u.pn * BM + wc * 32 + 4 * fq;
#pragma unroll
        for (int ai = 0; ai < 2; ++ai)
#pragma unroll
            for (int m = 0; m < 4; ++m) {
                const int row = u.pm * BM + ai * HALF + wr * 64 + m * 16 + fr;
                const size_t off = (size_t)row * 1024 + col0;
                float ss = 0.f;
#pragma unroll
                for (int bj = 0; bj < 2; ++bj)
#pragma unroll
                    for (int n = 0; n < 2; ++n) {
                        const f32x4 o = *(const f32x4*)(res + off + bj * HALF + n * 16) + acc[ai][bj][m][n];
                        *(f32x4*)(out + off + bj * HALF + n * 16) = o;
                        if (write_hb) {
                            u32x2 w; w.x = cvt_pk_bf16(o[0], o[1]); w.y = cvt_pk_bf16(o[2], o[3]);
                            *(u32x2*)(hb + off + bj * HALF + n * 16) = w;
                            ss += (o[0] * o[0] + o[1] * o[1]) + (o[2] * o[2] + o[3] * o[3]);
                        }
                    }
                if (write_hb) {
                    ss += __shfl_xor(ss, 16); ss += __shfl_xor(ss, 32);
                    if (fq == 0) hss[(size_t)row * 16 + u.pn * 4 + wc] = ss;
                }
                if (m & 1) asm volatile("" ::: "memory");
            }
    }
};

template <class Epi, class Sched, bool ALIGN_EPI = false, bool SP2 = false>
__device__ __forceinline__ void gemm_phase(PG8_LAS unsigned char* lds, const Gemm g, const Sched& S, const Epi& E) {
    int tid_ = threadIdx.x; asm volatile("" : "+v"(tid_));
    const int tid = tid_, wid = __builtin_amdgcn_readfirstlane(tid >> 6), lane = tid & 63, wr = wid >> 2, wc = wid & 3, fr = lane & 15, fq = lane >> 4;
    const int K = g.K, nt = K / BK;
    unsigned voffA[2], voffB[2];
#pragma unroll
    for (int i = 0; i < 2; ++i) { int R, C; stage_rc(tid * 16 + i * 8192, R, C); const int Rb = Epi::PERM ? ((R & ~31) + perm32(R & 31)) : R;
        voffA[i] = (unsigned)(R * K + C) * 2u; voffB[i] = (unsigned)(Rb * K + C) * 2u; }
    const size_t kstep = (size_t)(BK * 2);
    const size_t hstep = (size_t)HALF * K * 2;
    const size_t tstep = 2 * hstep;
    const unsigned ldsw = (unsigned)wid * 1024u;
    const int aoff = lds_byte(wr * 64 + fr, fq * 8), boff = lds_byte(wc * 32 + fr, fq * 8);
#define PG8_SA(b, h) (((b) * 2 + (h)) * HTB)
#define PG8_SB(b, h) ((4 + (b) * 2 + (h)) * HTB)
#define PG8_STAGE(bufoff, gbase, voff) do { _Pragma("unroll") for (int _i = 0; _i < 2; ++_i) \
        __builtin_amdgcn_global_load_lds((const unsigned*)((const char*)(gbase) + (voff)[_i]), (PG8_LAS unsigned*)(lds + (bufoff) + ldsw + _i * 8192), 16, 0, 0); } while (0)
#define PG8_LDA(dst, b, h) do { _Pragma("unroll") for (int m = 0; m < 4; ++m) _Pragma("unroll") for (int k = 0; k < 2; ++k) dst[m][k] = *(const PG8_LAS bf16x8*)(lds + PG8_SA(b, h) + aoff + m * 2048 + k * 1024); } while (0)
#define PG8_LDB(dst, b, h) do { _Pragma("unroll") for (int n = 0; n < 2; ++n) _Pragma("unroll") for (int k = 0; k < 2; ++k) dst[n][k] = *(const PG8_LAS bf16x8*)(lds + PG8_SB(b, h) + boff + n * 2048 + k * 1024); } while (0)
#define PG8_MMA(ai, bj, At, Bt) do { __builtin_amdgcn_s_setprio(1); _Pragma("unroll") for (int m = 0; m < 4; ++m) _Pragma("unroll") for (int n = 0; n < 2; ++n) _Pragma("unroll") for (int k = 0; k < 2; ++k) \
        acc[ai][bj][m][n] = __builtin_amdgcn_mfma_f32_16x16x32_bf16(Bt[n][k], At[m][k], acc[ai][bj][m][n], 0, 0, 0); __builtin_amdgcn_s_setprio(0); } while (0)
#define PG8_WAIT_V(n) asm volatile("s_waitcnt vmcnt(" #n ")" ::: "memory")
#define PG8_WAIT_L(n) asm volatile("s_waitcnt lgkmcnt(" #n ")" ::: "memory")
#define PG8_BAR __builtin_amdgcn_s_barrier()
#define PG8_SCHED __builtin_amdgcn_sched_barrier(0)
    Unit cur, nxt; int ui = 0;
    if (!S.next(0, cur)) return;
    f32x4 acc[2][2][4][2];
#pragma unroll
    for (int a = 0; a < 2; ++a)
#pragma unroll
        for (int b = 0; b < 2; ++b)
#pragma unroll
            for (int m = 0; m < 4; ++m)
#pragma unroll
                for (int n = 0; n < 2; ++n) acc[a][b][m][n] = (f32x4){0.f, 0.f, 0.f, 0.f};
    bf16x8 At[4][2], B0[2][2], B1[2][2];
    const char* cA = (const char*)g.A + (size_t)cur.pm * tstep; const char* cB = (const char*)g.Bt + (size_t)cur.pn * tstep;
    S.a_ready(cur);
    if constexpr (SP2) {
        PG8_STAGE(PG8_SB(0, 0), cB, voffB); PG8_STAGE(PG8_SB(0, 1), cB + hstep, voffB); PG8_STAGE(PG8_SA(0, 0), cA, voffA); PG8_STAGE(PG8_SA(0, 1), cA + hstep, voffA);
        if (wr == 1) PG8_BAR;
        PG8_WAIT_V(2); PG8_BAR;
        PG8_STAGE(PG8_SB(1, 0), cB + kstep, voffB); PG8_STAGE(PG8_SA(1, 0), cA + kstep, voffA); PG8_STAGE(PG8_SB(1, 1), cB + hstep + kstep, voffB);
        PG8_WAIT_V(6); PG8_BAR;
    } else {
        PG8_STAGE(PG8_SB(0, 0), cB, voffB); PG8_STAGE(PG8_SA(0, 0), cA, voffA); PG8_STAGE(PG8_SB(0, 1), cB + hstep, voffB); PG8_STAGE(PG8_SA(0, 1), cA + hstep, voffA);
        if (wr == 1) PG8_BAR;
        PG8_WAIT_V(4); PG8_BAR;
        PG8_STAGE(PG8_SB(1, 0), cB + kstep, voffB); PG8_STAGE(PG8_SA(1, 0), cA + kstep, voffA); PG8_STAGE(PG8_SB(1, 1), cB + hstep + kstep, voffB);
        PG8_WAIT_V(6); PG8_BAR;
    }
    for (;;) {
        const bool has_next = S.next(ui + 1, nxt);
        const char* nA = has_next ? (const char*)g.A + (size_t)nxt.pm * tstep : cA; const char* nB = has_next ? (const char*)g.Bt + (size_t)nxt.pn * tstep : cB;
        for (int t = 0; t < nt; t += 2) {
            const bool last = (t == nt - 2);
            const char* a1 = cA + (size_t)(t + 1) * kstep;
            const char* a2 = last ? nA : cA + (size_t)(t + 2) * kstep; const char* b2 = last ? nB : cB + (size_t)(t + 2) * kstep;
            const char* a3 = a2 + kstep; const char* b3 = b2 + kstep;
            if (last && has_next) S.a_ready(nxt);
            if constexpr (SP2) {
            PG8_LDB(B0, 0, 0); PG8_LDB(B1, 0, 1); PG8_SCHED; PG8_LDA(At, 0, 0); PG8_STAGE(PG8_SA(1, 1), a1 + hstep, voffA);
            PG8_WAIT_V(8); PG8_WAIT_L(0); PG8_BAR; PG8_MMA(0, 0, At, B0); PG8_MMA(0, 1, At, B1); PG8_BAR; PG8_SCHED;
            PG8_LDA(At, 0, 1); PG8_STAGE(PG8_SB(0, 0), b2, voffB); PG8_STAGE(PG8_SB(0, 1), b2 + hstep, voffB); PG8_STAGE(PG8_SA(0, 0), a2, voffA);
            PG8_WAIT_V(8); PG8_WAIT_L(0); PG8_BAR; PG8_MMA(1, 0, At, B0); PG8_MMA(1, 1, At, B1); PG8_BAR; PG8_SCHED;
            PG8_LDB(B0, 1, 0); PG8_LDB(B1, 1, 1); PG8_SCHED; PG8_LDA(At, 1, 0); PG8_STAGE(PG8_SA(0, 1), a2 + hstep, voffA);
            PG8_WAIT_V(8); PG8_WAIT_L(0); PG8_BAR; PG8_MMA(0, 0, At, B0); PG8_MMA(0, 1, At, B1); PG8_BAR; PG8_SCHED;
            PG8_LDA(At, 1, 1); PG8_STAGE(PG8_SB(1, 0), b3, voffB); PG8_STAGE(PG8_SB(1, 1), b3 + hstep, voffB); PG8_STAGE(PG8_SA(1, 0), a3, voffA);
            PG8_WAIT_V(8); PG8_WAIT_L(0); PG8_BAR; PG8_MMA(1, 0, At, B0); PG8_MMA(1, 1, At, B1); PG8_BAR; PG8_SCHED;
            } else {
            PG8_LDB(B0, 0, 0); PG8_SCHED; PG8_LDA(At, 0, 0); PG8_STAGE(PG8_SA(1, 1), a1 + hstep, voffA);
            PG8_WAIT_L(8); PG8_BAR; PG8_WAIT_L(0); PG8_MMA(0, 0, At, B0); PG8_BAR; PG8_SCHED;
            PG8_LDB(B1, 0, 1); PG8_STAGE(PG8_SB(0, 0), b2, voffB);
            PG8_BAR; PG8_WAIT_L(0); PG8_MMA(0, 1, At, B1); PG8_BAR;
            PG8_LDA(At, 0, 1); PG8_STAGE(PG8_SA(0, 0), a2, voffA);
            PG8_BAR; PG8_WAIT_L(0); PG8_MMA(1, 0, At, B0); PG8_BAR; PG8_SCHED;
            PG8_STAGE(PG8_SB(0, 1), b2 + hstep, voffB);
            PG8_WAIT_V(6); PG8_BAR; PG8_MMA(1, 1, At, B1); PG8_BAR;
            PG8_LDB(B0, 1, 0); PG8_SCHED; PG8_LDA(At, 1, 0); PG8_STAGE(PG8_SA(0, 1), a2 + hstep, voffA);
            PG8_WAIT_L(8); PG8_BAR; PG8_WAIT_L(0); PG8_MMA(0, 0, At, B0); PG8_BAR; PG8_SCHED;
            PG8_LDB(B1, 1, 1); PG8_STAGE(PG8_SB(1, 0), b3, voffB);
            PG8_BAR; PG8_WAIT_L(0); PG8_MMA(0, 1, At, B1); PG8_BAR;
            PG8_LDA(At, 1, 1); PG8_STAGE(PG8_SA(1, 0), a3, voffA);
            PG8_BAR; PG8_WAIT_L(0); PG8_MMA(1, 0, At, B0); PG8_BAR; PG8_SCHED;
            PG8_STAGE(PG8_SB(1, 1), b3 + hstep, voffB);
            PG8_WAIT_V(6); PG8_BAR; PG8_MMA(1, 1, At, B1); PG8_BAR;
            }
        }
        if constexpr (ALIGN_EPI) { if (wr == 0) PG8_BAR; }
        if constexpr (!Epi::AFTER_DRAIN) { E(acc, cur, wr, wc, fr, fq); S.done(cur); }
        if (!has_next) break;
#pragma unroll
        for (int a = 0; a < 2; ++a)
#pragma unroll
            for (int b = 0; b < 2; ++b)
#pragma unroll
                for (int m = 0; m < 4; ++m)
#pragma unroll
                    for (int n = 0; n < 2; ++n) acc[a][b][m][n] = (f32x4){0.f, 0.f, 0.f, 0.f};
        cur = nxt; cA = nA; cB = nB; ++ui;
        if constexpr (ALIGN_EPI) { if (wr == 1) PG8_BAR; }
    }
    PG8_WAIT_V(0);
    if constexpr (!ALIGN_EPI) { if (wr == 0) PG8_BAR; }
    PG8_BAR;
    if constexpr (Epi::AFTER_DRAIN) { E.fused(acc, cur, wr, wc, fr, fq, lds, wid, lane); S.done(cur); }
#undef PG8_SA
#undef PG8_SB
#undef PG8_STAGE
#undef PG8_LDA
#undef PG8_LDB
#undef PG8_MMA
#undef PG8_WAIT_V
#undef PG8_WAIT_L
#undef PG8_BAR
#undef PG8_SCHED
}
}

#define LAS __attribute__((address_space(3)))
typedef unsigned short bf16_t;
typedef short bf16x8 __attribute__((ext_vector_type(8)));
typedef short s16x4 __attribute__((ext_vector_type(4)));
typedef float f32x4 __attribute__((ext_vector_type(4)));
typedef float f32x2 __attribute__((ext_vector_type(2)));
typedef float f32x16 __attribute__((ext_vector_type(16)));
typedef unsigned u32x4 __attribute__((ext_vector_type(4)));
typedef unsigned u32x2 __attribute__((ext_vector_type(2)));
typedef __bf16 bf16x2_t __attribute__((ext_vector_type(2)));
#define MFMA32(a, b, c) __builtin_amdgcn_mfma_f32_32x32x16_bf16((a), (b), (c), 0, 0, 0)

constexpr int NTOK = 32768, DM = 1024, SEQ = 4096, NIN = 8264, NINP = 8448, NCD = 4352, PP = 4160, MISCP = 80;
constexpr float LOG2E = 1.4426950408889634f;
constexpr size_t WS_CTL = 0, WS_BIAS = 16384, WS_WIN = 1u << 20, WS_WOUT = WS_WIN + (size_t)2 * NINP * 1024 * 2, WS_HB = WS_WOUT + (size_t)4 * 1024 * 1024 * 2,
                 WS_PROJ = WS_HB + (size_t)NTOK * 1024 * 2, WS_MISC = WS_PROJ + (size_t)NTOK * PP * 2, WS_MIXED = WS_MISC + (size_t)NTOK * MISCP * 4,
                 WS_HSS = WS_MIXED + (size_t)NTOK * 1024 * 2, WS_Q = WS_HSS + (size_t)NTOK * 16 * 4, WS_BON = WS_Q + (size_t)NTOK * 512 * 2,
                 WS_HE = WS_BON + (size_t)NTOK * 8 * 4, WS_PE = WS_HE + (size_t)256 * 4096 * 4, WS_END = WS_PE + (size_t)256 * 4096 * 4;
constexpr int QSLOT_OFF = 143360, LDS_BYTES = QSLOT_OFF + 1024;

__device__ __forceinline__ unsigned pk2(float lo, float hi) { f32x2 v = {lo, hi}; bf16x2_t b = __builtin_convertvector(v, bf16x2_t); return __builtin_bit_cast(unsigned, b); }
typedef short v4i16_t __attribute__((ext_vector_type(4)));
__device__ __forceinline__ s16x4 vtr(const LAS unsigned char* p) { return __builtin_bit_cast(s16x4, __builtin_amdgcn_ds_read_tr16_b64_v4i16((LAS v4i16_t*)p)); }
__device__ __forceinline__ float bflo(unsigned u) { return __uint_as_float(u << 16); }
__device__ __forceinline__ float bfhi(unsigned u) { return __uint_as_float(u & 0xffff0000u); }
__device__ __forceinline__ float ex2(float x) { return __builtin_amdgcn_exp2f(x); }
__device__ __forceinline__ float lg2(float x) { return __builtin_amdgcn_logf(x); }
__device__ __forceinline__ float wave_sum(float v) {
#pragma unroll
    for (int o = 1; o < 64; o <<= 1) v += __shfl_xor(v, o);
    return v;
}
__device__ __forceinline__ float dpp_xor1(float v) { return __int_as_float(__builtin_amdgcn_update_dpp(0, __float_as_int(v), 0xB1, 0xF, 0xF, true)); }
__device__ __forceinline__ float dpp_xor2(float v) { return __int_as_float(__builtin_amdgcn_update_dpp(0, __float_as_int(v), 0x4E, 0xF, 0xF, true)); }
__device__ __forceinline__ float dpp_hmir(float v) { return __int_as_float(__builtin_amdgcn_update_dpp(0, __float_as_int(v), 0x141, 0xF, 0xF, true)); }
__device__ __forceinline__ float red8(float v) { v += dpp_xor1(v); v += dpp_xor2(v); v += dpp_hmir(v); return v; }
__device__ __forceinline__ float silu(float g) { return g * __builtin_amdgcn_rcpf(1.0f + __expf(-g)); }

struct Args {
    const float *x, *norm_gain, *w_in, *w_out, *rel_bias, *qk_gain, *diff_lambda, *forget_bias, *out_gain, *rwkv_mu, *rwkv_w_up, *rwkv_w0, *rwkv_a_up, *rwkv_a0, *rwkv_kkr, *rwkv_ln_gain, *rwkv_ln_bias;
    float* out; unsigned char* ws; int ph_lo, ph_hi;
};

__device__ __forceinline__ int refcol_in(int np) {
    if (np < 2048) return 4096 + np;
    if (np < 3584) return 6152 + (np - 2048);
    if (np < 4096) return 7752 + (np - 3584);
    if (np < 4160) return 7688 + (np - 4096);
    if (np < 4168) return 6144 + (np - 4160);
    if (np < 4352) return -1;
    return np - 4352;
}
template <bool MAPPED>
__device__ __forceinline__ void transpose_item(const float* W, int ldw, const float* gain, bf16_t* WT, LAS float* scr, int kb, int nb, int lane) {
    const int k0 = 64 * kb, n0 = 32 * nb;
    int rc = n0 + (lane & 31);
    if (MAPPED) rc = refcol_in(rc);
    float tv_[32];
#pragma unroll
    for (int i = 0; i < 32; ++i) {
        const int kk = 2 * i + (lane >> 5);
        float v = 0.f;
        if (rc >= 0) { v = W[(size_t)(k0 + kk) * ldw + rc]; if (MAPPED) v *= gain[k0 + kk]; }
        tv_[i] = v;
    }
#pragma unroll
    for (int i = 0; i < 32; ++i) scr[(2 * i + (lane >> 5)) * 33 + (lane & 31)] = tv_[i];
    asm volatile("s_waitcnt lgkmcnt(0)" ::: "memory");
    const int c = lane & 7;
#pragma unroll
    for (int j = 0; j < 4; ++j) {
        const int n = (lane >> 3) + 8 * j; const LAS float* s = scr + (8 * c) * 33 + n;
        u32x4 o; o.x = pk2(s[0 * 33], s[1 * 33]); o.y = pk2(s[2 * 33], s[3 * 33]); o.z = pk2(s[4 * 33], s[5 * 33]); o.w = pk2(s[6 * 33], s[7 * 33]);
        *(u32x4*)(WT + (size_t)(n0 + n) * 1024 + k0 + 8 * c) = o;
    }
    asm volatile("s_waitcnt lgkmcnt(0)" ::: "memory");
}

__device__ __forceinline__ void prologue(const Args& a, LAS unsigned char* lds) {
    const int tid = threadIdx.x, lane = tid & 63, wave = tid >> 6;
    LAS float* scr = (LAS float*)(lds + wave * 8704);
    const int gw = blockIdx.x * 8 + wave, NGW = gridDim.x * 8;
    bf16_t* WtIn = (bf16_t*)(a.ws + WS_WIN); bf16_t* WtOut = (bf16_t*)(a.ws + WS_WOUT);
    constexpr int I_IN = 16 * (NINP / 32), I_OUT = 16 * 32;
    constexpr int NITEMS = 2 * I_IN + 4 * I_OUT;
    for (int it = gw; it < NITEMS; it += NGW) {
        if (it < 2 * I_IN) {
            const int l = it / I_IN, r = it % I_IN, kb = r / (NINP / 32), nb = r % (NINP / 32);
            transpose_item<true>(a.w_in + (size_t)l * 1024 * NIN, NIN, a.norm_gain + l * 1024, WtIn + (size_t)l * NINP * 1024, scr, kb, nb, lane);
        } else {
            const int r0 = it - 2 * I_IN, mi = r0 / I_OUT, r = r0 % I_OUT, kb = r / 32, nb = r % 32, l = mi >> 1, half = mi & 1;
            transpose_item<false>(a.w_out + (size_t)l * 2048 * 1024 + (size_t)(half == 0 ? 1024 : 0) * 1024, 1024, nullptr, WtOut + (size_t)mi * 1024 * 1024, scr, kb, nb, lane);
        }
    }
    bf16_t* hb = (bf16_t*)(a.ws + WS_HB); float* hss = (float*)(a.ws + WS_HSS);
    for (int m0 = gw * 4; m0 < NTOK; m0 += NGW * 4) {
        f32x4 v[4][4];
#pragma unroll
        for (int r = 0; r < 4; ++r) { const f32x4* xr = (const f32x4*)(a.x + (size_t)(m0 + r) * 1024) + lane;
#pragma unroll
            for (int j = 0; j < 4; ++j) v[r][j] = xr[64 * j]; }
#pragma unroll
        for (int r = 0; r < 4; ++r) {
            float s = 0.f;
#pragma unroll
            for (int j = 0; j < 4; ++j) s += (v[r][j][0] * v[r][j][0] + v[r][j][1] * v[r][j][1]) + (v[r][j][2] * v[r][j][2] + v[r][j][3] * v[r][j][3]);
            s = wave_sum(s);
            u32x2* o8 = (u32x2*)(hb + (size_t)(m0 + r) * 1024) + lane;
#pragma unroll
            for (int j = 0; j < 4; ++j) { u32x2 w; w.x = pk2(v[r][j][0], v[r][j][1]); w.y = pk2(v[r][j][2], v[r][j][3]); o8[64 * j] = w; }
            if (lane < 16) hss[(size_t)(m0 + r) * 16 + lane] = (lane == 0) ? s : 0.f;
        }
    }
    if (blockIdx.x == 0) {
        float* bt = (float*)(a.ws + WS_BIAS);
        for (int e = tid; e < 1024; e += 512) {
            const int h = e >> 8, d = e & 255;
            int bk;
            if (d < 16) bk = d;
            else { const float lg = logf((float)d / 16.0f) / 2.0794415416798357f * 16.0f; bk = 16 + (int)lg; if (bk > 31) bk = 31; }
            bt[e] = a.rel_bias[bk * 4 + h] * LOG2E;
        }
    }
}

struct AttnP {
    const bf16_t* P; bf16_t* mixed; const float* misc;
    const float* qk_gain;
    const float* out_gain;
    const float* biasT;
    const float* fbias;
    float lam, oml;
};
__device__ __forceinline__ int crow(int r, int hi) { return (r & 3) + 8 * (r >> 2) + 4 * hi; }

template <int MODE>
__device__ __forceinline__ void attn_item(const AttnP& p, int b, int h, int qb, LAS unsigned char* lds) {
    constexpr int NC = (MODE == 0) ? 2 : 1, DK = 64 * NC, DV = 64 * NC, KP = DK + 8, VPT = DV + 32;
    constexpr int KS_BYTES = 64 * KP * 2, VT_BYTES = 64 * VPT * 2, BUF_BYTES = KS_BYTES + VT_BYTES + 256;
    constexpr int TAB_OFF = 2 * BUF_BYTES, FLAG_OFF = TAB_OFF + 1024, QP_OFF = FLAG_OFF + 512;
    constexpr bool QPARK = (MODE == 0);
    int tid_ = threadIdx.x; asm volatile("" : "+v"(tid_));
    const int tid = tid_, lane = tid & 63, w = __builtin_amdgcn_readfirstlane(tid >> 6), hh = lane >> 5, ln = lane & 31;
    const int qcol = ((MODE == 1) ? 2048 : 0) + h * DK, kcol = qcol + 512, vcol = qcol + 1024, gcol = qcol + 1536;
    const int mixcol = ((MODE == 1) ? 512 : 0) + h * DV;
    const int gaincol = ((MODE == 0) ? 0 : (MODE == 1) ? 512 : 1024) + h * DV;
    const int tok0 = b * SEQ, q0 = qb * 256, qw = q0 + 32 * w, qrow = qw + ln;
    const bf16_t* P = p.P;

    bf16x8 Qf[NC][4];
#pragma unroll
    for (int c = 0; c < NC; ++c) {
        u32x4 raw[4]; float ss = 0.f;
#pragma unroll
        for (int ks = 0; ks < 4; ++ks) {
            raw[ks] = *(const u32x4*)(P + (size_t)(tok0 + qrow) * PP + qcol + c * 64 + ks * 16 + hh * 8);
#pragma unroll
            for (int e = 0; e < 4; ++e) { const float lo = bflo(raw[ks][e]), hi = bfhi(raw[ks][e]); ss += lo * lo + hi * hi; }
        }
        float sc = 0.125f * LOG2E;
        if (MODE != 1) { ss += __shfl_xor(ss, 32); sc *= 1.0f / sqrtf(ss * (1.0f / 64.0f) + 1e-6f); }
#pragma unroll
        for (int ks = 0; ks < 4; ++ks) {
            u32x4 o;
#pragma unroll
            for (int e = 0; e < 4; ++e) {
                float lo = bflo(raw[ks][e]) * sc, hi = bfhi(raw[ks][e]) * sc;
                if (MODE != 1) {
                    const int d = ks * 16 + hh * 8 + 2 * e;
                    const float* gq = p.qk_gain + ((MODE == 0) ? 0 : 128); const float* gk = gq + 64;
                    lo *= gq[d] * gk[d]; hi *= gq[d + 1] * gk[d + 1];
                }
                o[e] = pk2(lo, hi);
            }
            Qf[c][ks] = __builtin_bit_cast(bf16x8, o);
            if (QPARK) *(LAS u32x4*)(lds + QP_OFF + w * 8192 + ((c * 4 + ks) * 64 + lane) * 16) = o;
        }
    }
    if (MODE == 0) { LAS float* tab = (LAS float*)(lds + TAB_OFF); if (tid < 256) tab[tid] = p.biasT[h * 256 + tid]; }
    LAS unsigned* flags = (LAS unsigned*)(lds + FLAG_OFF);
    if (MODE == 1 && tid < 16) flags[tid] = 0u;

    f32x16 O[NC][DV / 32];
#pragma unroll
    for (int c = 0; c < NC; ++c)
#pragma unroll
        for (int d = 0; d < DV / 32; ++d)
#pragma unroll
            for (int i = 0; i < 16; ++i) O[c][d][i] = 0.f;
    float mrun[NC], lsum[NC];
#pragma unroll
    for (int c = 0; c < NC; ++c) { mrun[c] = -1e30f; lsum[c] = 0.f; }
    float R2 = 0.f; bool mydone = false;
    float carry = 0.f, bq0 = 0.f, qk2 = 0.f;
    LAS unsigned* cflags = flags + 32;
    if (MODE == 2) {
        if (tid < 4) cflags[tid] = 0u;
        float gq_ = fabsf(p.qk_gain[128 + lane]), gk_ = fabsf(p.qk_gain[192 + lane]);
#pragma unroll
        for (int o_ = 1; o_ < 64; o_ <<= 1) { gq_ = fmaxf(gq_, __shfl_xor(gq_, o_)); gk_ = fmaxf(gk_, __shfl_xor(gk_, o_)); }
        qk2 = 8.0f * gq_ * gk_ * LOG2E * 1.02f;
    }
    const float fb = (MODE == 2) ? p.fbias[h] : 0.f;

    const int jt_max = qb * 4 + 3;
    u32x4 kreg[NC], vreg[NC]; float cfreg = 0.f;
#define ATT_LOADK(jt) do { _Pragma("unroll") for (int i_ = 0; i_ < NC; ++i_) { const int key_ = tid >> 3, dch_ = (tid & 7) + 8 * i_; \
            const bf16_t* rp_ = P + (size_t)(tok0 + (jt) * 64 + key_) * PP + dch_ * 8; kreg[i_] = *(const u32x4*)(rp_ + kcol); } \
        if (MODE == 2 && w == 0) cfreg = p.misc[(size_t)(tok0 + (jt) * 64 + lane) * MISCP + 64 + h]; } while (0)
#define ATT_LOADV(jt) do { _Pragma("unroll") for (int i_ = 0; i_ < NC; ++i_) { const int key_ = tid >> 3, dch_ = (tid & 7) + 8 * i_; \
            const bf16_t* rp_ = P + (size_t)(tok0 + (jt) * 64 + key_) * PP + dch_ * 8; vreg[i_] = *(const u32x4*)(rp_ + vcol); } } while (0)
#define ATT_LOAD(jt) do { ATT_LOADK(jt); ATT_LOADV(jt); } while (0)
#define ATT_STORE(buf, T_) do { LAS unsigned char* kb_ = lds + (buf) * BUF_BYTES; LAS unsigned char* vb_ = kb_ + KS_BYTES; \
        _Pragma("unroll") for (int i_ = 0; i_ < NC; ++i_) { const int key_ = tid >> 3, dch_ = (tid & 7) + 8 * i_; \
            u32x4 kv_ = kreg[i_]; \
            if (MODE != 1) { float ss_ = 0.f; _Pragma("unroll") for (int e_ = 0; e_ < 4; ++e_) { const float lo_ = bflo(kv_[e_]), hi_ = bfhi(kv_[e_]); ss_ += lo_ * lo_ + hi_ * hi_; } \
                ss_ = red8(ss_); const float inv_ = __builtin_amdgcn_rsqf(ss_ * (1.0f / 64.0f) + 1e-6f); \
                _Pragma("unroll") for (int e_ = 0; e_ < 4; ++e_) kv_[e_] = pk2(bflo(kv_[e_]) * inv_, bfhi(kv_[e_]) * inv_); } \
            *(LAS u32x4*)(kb_ + (key_ * KP + dch_ * 8) * 2) = kv_; \
            const u32x4 vv_ = vreg[i_]; \
            *(LAS u32x4*)(vb_ + (key_ * VPT + dch_ * 8) * 2) = vv_; } \
        if (MODE == 2 && w == 0) { const float x_ = cfreg + fb; const float lf_ = fminf(x_, 0.f) - __logf(1.0f + __expf(-fabsf(x_))); float s_ = lf_; \
            _Pragma("unroll") for (int o_ = 1; o_ < 64; o_ <<= 1) { const float t_ = __shfl_down(s_, o_); if (lane + o_ < 64) s_ += t_; } \
            const float bval_ = (carry + (s_ - lf_)) * LOG2E; ((LAS float*)(vb_ + VT_BYTES))[lane] = bval_ - qk2; carry += __shfl(s_, 0); \
            if ((T_) == 4 * qb) bq0 = __shfl(bval_, 0); \
            const bool ex_ = ((T_) <= 4 * qb) && (12.0f + 2.0f * qk2 + carry * LOG2E - bq0 < -32.0f); \
            if (lane == 0) cflags[(T_) & 3] = ex_ ? 1u : 0u; } } while (0)

    ATT_LOAD(jt_max);
    ATT_STORE(0, jt_max);
    __syncthreads();
    float mfix = 0.f;
    if (MODE == 2) mfix = qk2;
    if (MODE == 0) {
        float gq_ = fabsf(p.qk_gain[lane]), gk_ = fabsf(p.qk_gain[64 + lane]);
        const LAS float* tab_ = (const LAS float*)(lds + TAB_OFF);
        float tm_ = fmaxf(fmaxf(fabsf(tab_[lane]), fabsf(tab_[64 + lane])), fmaxf(fabsf(tab_[128 + lane]), fabsf(tab_[192 + lane])));
#pragma unroll
        for (int o_ = 1; o_ < 64; o_ <<= 1) { gq_ = fmaxf(gq_, __shfl_xor(gq_, o_)); gk_ = fmaxf(gk_, __shfl_xor(gk_, o_)); tm_ = fmaxf(tm_, __shfl_xor(tm_, o_)); }
        mfix = 8.0f * gq_ * gk_ * LOG2E * 1.02f + tm_;
    }
    for (int it = 0; it <= jt_max; ++it) {
        const int jt = jt_max - it, k0 = jt * 64, buf = it & 1;
        const bool has_next = it < jt_max;
        if (has_next) { ATT_LOADK(jt - 1); ATT_LOADV(jt - 1); }
        LAS unsigned char* ksb = lds + buf * BUF_BYTES; LAS unsigned char* vtb = ksb + KS_BYTES;
#pragma unroll
        for (int kb2 = 1; kb2 >= 0; --kb2) {
            const int kp0 = k0 + 32 * kb2;
            bool active = (MODE == 1) ? (kp0 <= qw + 30) : (kp0 <= qw + 31);
            if (MODE == 1) active = active && !mydone;
            if (active) {
                f32x16 S[NC];
#define ATT_QK(c, INIT) do { _Pragma("unroll") for (int i = 0; i < 16; ++i) S[c][i] = (INIT); \
                    _Pragma("unroll") for (int ks = 0; ks < 4; ++ks) { const bf16x8 ka = *(const LAS bf16x8*)(ksb + ((32 * kb2 + ln) * KP + (c) * 64 + ks * 16 + hh * 8) * 2); const bf16x8 qf_ = (QPARK && (c) == 1) ? *(const LAS bf16x8*)(lds + QP_OFF + w * 8192 + (((c) * 4 + ks) * 64 + lane) * 16) : Qf[(QPARK && (c) == 1) ? 0 : (c)][ks]; S[c] = MFMA32(ka, qf_, S[c]); } } while (0)
                if (MODE == 1) ATT_QK(0, 0.f);
                const bool need_mask = (MODE == 1) ? (kp0 + 31 >= qw) : (kp0 + 31 > qw);
                bf16x8 pb[NC][2];
                if (MODE == 1) {
                    float L2[16], z2[16];
#pragma unroll
                    for (int i = 0; i < 16; ++i) {
                        z2[i] = S[0][i];
                        const bool valid = !need_mask || (kp0 + crow(i, hh) < qrow);
                        const float sp = fmaxf(z2[i], 0.f) + lg2(1.0f + ex2(-fabsf(z2[i])));
                        L2[i] = valid ? -sp : 0.f;
                    }
                    float G[4], PG[4], ag[4];
#pragma unroll
                    for (int g = 0; g < 4; ++g) { G[g] = (L2[4 * g] + L2[4 * g + 1]) + (L2[4 * g + 2] + L2[4 * g + 3]); PG[g] = __shfl_xor(G[g], 32); }
                    float accg = 0.f;
#pragma unroll
                    for (int g = 3; g >= 0; --g) { ag[g] = accg + (hh == 0 ? PG[g] : 0.f); accg += G[g] + PG[g]; }
                    float A[16];
#pragma unroll
                    for (int g = 0; g < 4; ++g) {
                        const float base = R2 + ag[g];
                        const float w3 = 0.f, w2 = L2[4 * g + 3], w1 = w2 + L2[4 * g + 2], w0 = w1 + L2[4 * g + 1];
                        const float wi[4] = {w0, w1, w2, w3};
#pragma unroll
                        for (int e = 0; e < 4; ++e) {
                            const int i = 4 * g + e;
                            const bool valid = !need_mask || (kp0 + crow(i, hh) < qrow);
                            A[i] = valid ? ex2(z2[i] + L2[i] + base + wi[e]) : 0.f;
                        }
                    }
                    R2 += accg;
#pragma unroll
                    for (int t2 = 0; t2 < 2; ++t2) {
                        u32x4 o; o.x = pk2(A[8 * t2], A[8 * t2 + 1]); o.y = pk2(A[8 * t2 + 2], A[8 * t2 + 3]); o.z = pk2(A[8 * t2 + 4], A[8 * t2 + 5]); o.w = pk2(A[8 * t2 + 6], A[8 * t2 + 7]);
                        pb[0][t2] = __builtin_bit_cast(bf16x8, o);
                    }
                } else {
#define ATT_TAIL(c) do { float ps = 0.f; float pe[16]; _Pragma("unroll") for (int i = 0; i < 16; ++i) { pe[i] = ex2(S[c][i]); ps += pe[i]; } lsum[c] += ps; \
                        _Pragma("unroll") for (int t2 = 0; t2 < 2; ++t2) { u32x4 o; o.x = pk2(pe[8 * t2], pe[8 * t2 + 1]); o.y = pk2(pe[8 * t2 + 2], pe[8 * t2 + 3]); o.z = pk2(pe[8 * t2 + 4], pe[8 * t2 + 5]); o.w = pk2(pe[8 * t2 + 6], pe[8 * t2 + 7]); \
                            pb[c][t2] = __builtin_bit_cast(bf16x8, o); } } while (0)
                    if (MODE == 0) {
                        const LAS float* tab = (const LAS float*)(lds + TAB_OFF);
                        if (qw - (kp0 + 31) >= 128) {
                            const float cb = tab[255] - mfix;
#pragma unroll
                            for (int c = 0; c < NC; ++c) { ATT_QK(c, cb); ATT_TAIL(c); }
                        } else {
                            float binit[16];
#pragma unroll
                            for (int i = 0; i < 16; ++i) {
                                const int dist = qrow - (kp0 + crow(i, hh));
                                binit[i] = (dist < 0) ? -3e38f : (tab[dist > 255 ? 255 : dist] - mfix);
                            }
#pragma unroll
                            for (int c = 0; c < NC; ++c) { ATT_QK(c, binit[i]); ATT_TAIL(c); }
                        }
                    } else {
                        float binit[16];
                        const LAS float* bl = (const LAS float*)(vtb + VT_BYTES) + 32 * kb2 + 4 * hh;
#pragma unroll
                        for (int g = 0; g < 4; ++g) {
                            const f32x4 t = *(const LAS f32x4*)(bl + 8 * g);
#pragma unroll
                            for (int e = 0; e < 4; ++e) binit[4 * g + e] = (need_mask && (kp0 + crow(4 * g + e, hh) > qrow)) ? -3e38f : t[e];
                        }
                        ATT_QK(0, binit[i]); ATT_TAIL(0);
                    }
#undef ATT_TAIL
                }
#pragma unroll
                for (int t2 = 0; t2 < 2; ++t2)
#pragma unroll
                    for (int d = 0; d < DV / 32; ++d) {
                        const LAS unsigned char* vp = vtb + ((32 * kb2 + 16 * t2 + 4 * hh + ((lane & 15) >> 2)) * VPT + d * 32 + 16 * ((lane >> 4) & 1) + 4 * (lane & 3)) * 2;
                        const s16x4 lo = vtr(vp), hi = vtr(vp + 8 * VPT * 2);
                        const bf16x8 va = __builtin_shufflevector(lo, hi, 0, 1, 2, 3, 4, 5, 6, 7);
#pragma unroll
                        for (int c = 0; c < NC; ++c) O[c][d] = MFMA32(va, pb[c][t2], O[c][d]);
                    }
            }
        }
        if (MODE == 1) {
            if (!mydone && __all(R2 < -45.0f)) mydone = true;
            if (lane == 0) flags[(it & 1) * 8 + w] = mydone ? 1u : 0u;
        }
        if (has_next) { ATT_STORE(buf ^ 1, jt - 1); }
        __syncthreads();
        if (MODE == 2) { if (cflags[jt & 3]) break; }
        if (MODE == 1) {
            unsigned alld = 1u;
#pragma unroll
            for (int i = 0; i < 8; ++i) alld &= flags[(it & 1) * 8 + i];
            if (alld) break;
        }
    }
#undef ATT_LOAD
#undef ATT_LOADK
#undef ATT_LOADV
#undef ATT_STORE
    float inv0 = 1.f, inv1 = 0.f;
    if (MODE != 1) { float l0 = lsum[0]; l0 += __shfl_xor(l0, 32); inv0 = 1.0f / l0; }
    if (MODE == 0) { float l1 = lsum[NC - 1]; l1 += __shfl_xor(l1, 32); inv1 = p.lam / l1; }
    float ss = 0.f;
#pragma unroll
    for (int d = 0; d < DV / 32; ++d)
#pragma unroll
        for (int i = 0; i < 16; ++i) {
            float o = O[0][d][i] * inv0;
            if (MODE == 0) o -= O[NC - 1][d][i] * inv1;
            O[0][d][i] = o; ss += o * o;
        }
    ss += __shfl_xor(ss, 32);
    float rn = 1.0f / sqrtf(ss * (1.0f / DV) + 1e-6f);
    if (MODE == 0) rn *= p.oml;
    int qrow_e = qrow; asm volatile("" : "+v"(qrow_e));
    const size_t trow = (size_t)(tok0 + qrow_e);
#pragma unroll
    for (int d = 0; d < DV / 32; ++d)
#pragma unroll
        for (int g = 0; g < 4; ++g) {
            const int dd = d * 32 + 8 * g + 4 * hh;
            const u32x2 gr = *(const u32x2*)(P + trow * PP + gcol + dd);
            const f32x4 og = *(const f32x4*)(p.out_gain + gaincol + dd);
            const float o0 = O[0][d][4 * g] * rn * og[0] * silu(bflo(gr.x)), o1 = O[0][d][4 * g + 1] * rn * og[1] * silu(bfhi(gr.x));
            const float o2 = O[0][d][4 * g + 2] * rn * og[2] * silu(bflo(gr.y)), o3 = O[0][d][4 * g + 3] * rn * og[3] * silu(bfhi(gr.y));
            u32x2 wv; wv.x = pk2(o0, o1); wv.y = pk2(o2, o3);
            *(u32x2*)(p.mixed + trow * 1024 + mixcol + dd) = wv;
        }
}

struct ScanP {
    const bf16_t* P; bf16_t* mixed; const float* misc;
    const float *mu, *w_up, *w0, *a_up, *a0, *kkr, *ln_gain, *ln_bias, *out_gain;
    bf16_t* Q; float* bon; float* HE; float* PE;
};
__device__ __forceinline__ float red16(float v) { v = red8(v); v += __int_as_float(__builtin_amdgcn_update_dpp(0, __float_as_int(v), 0x140, 0xF, 0xF, true)); return v; }

__device__ __forceinline__ bf16x8 pack8(const f32x16& x, int s) {
    u32x4 o; o.x = pk2(x[8 * s], x[8 * s + 1]); o.y = pk2(x[8 * s + 2], x[8 * s + 3]); o.z = pk2(x[8 * s + 4], x[8 * s + 5]); o.w = pk2(x[8 * s + 6], x[8 * s + 7]);
    return __builtin_bit_cast(bf16x8, o);
}
__device__ __forceinline__ bf16x8 ld_krow(const LAS unsigned char* p) {
    const s16x4 lo = *(const LAS s16x4*)p, hi = *(const LAS s16x4*)(p + 16);
    return __builtin_shufflevector(lo, hi, 0, 1, 2, 3, 4, 5, 6, 7);
}
__device__ __forceinline__ void scan_pass1(const ScanP& sp, int b, int h, int seg, LAS unsigned char* lds) {
    int tid_ = threadIdx.x; asm volatile("" : "+v"(tid_));
    const int tid = tid_, lane = tid & 63, w = __builtin_amdgcn_readfirstlane(tid >> 6);
    constexpr int O_WUP = 0, O_AUP = 8192, O_LORA = 16384, O_LW = 24576, O_KK = 32768, O_R = 37376, O_K = 41984, O_B = 46592, O_KT = 51200, O_BT = 56320, O_VT = 61440,
                  O_MK = 66560, O_NK = 69120, O_TM = 71680, O_NB = 74240, O_NT = 76800, O_GAM = 80896, O_VV = 81152, O_SC = 89344, O_YB = 89856, O_N21 = 109056;
    LAS float* wup = (LAS float*)(lds + O_WUP); LAS float* aup = (LAS float*)(lds + O_AUP); LAS float* lora = (LAS float*)(lds + O_LORA); LAS float* lwS = (LAS float*)(lds + O_LW);
    LAS float* NT = (LAS float*)(lds + O_NT); LAS float* gam = (LAS float*)(lds + O_GAM); LAS float* vvv = (LAS float*)(lds + O_VV); LAS float* scl = (LAS float*)(lds + O_SC); LAS float* yb = (LAS float*)(lds + O_YB); LAS float* qb = (LAS float*)(lds + 100864);
    LAS float* stash = (LAS float*)(lds + 117248);
    const int tok0 = b * SEQ;
    const int tt = tid >> 4, jg = tid & 15, j4 = 4 * jg, ch = h * 64 + j4;
    __syncthreads();
    for (int e = tid; e < 2048; e += 512) { const int m = e >> 6, j = e & 63;
        ((LAS unsigned short*)(lds + O_WUP))[j * 40 + m] = (unsigned short)(pk2(sp.w_up[m * 512 + h * 64 + j], 0.f) & 0xffffu);
        ((LAS unsigned short*)(lds + O_WUP + 5120))[j * 40 + m] = (unsigned short)(pk2(sp.a_up[m * 512 + h * 64 + j], 0.f) & 0xffffu); }
    LAS float* par = (LAS float*)(lds + 98048);
    if (tid < 64) {
        const int c_ = h * 64 + tid;
        par[0 * 64 + tid] = sp.mu[c_]; par[1 * 64 + tid] = sp.mu[512 + c_]; par[2 * 64 + tid] = sp.mu[1024 + c_]; par[3 * 64 + tid] = sp.mu[1536 + tid];
        par[4 * 64 + tid] = sp.w0[c_]; par[5 * 64 + tid] = sp.a0[c_]; par[6 * 64 + tid] = sp.kkr[c_]; par[7 * 64 + tid] = sp.kkr[512 + c_]; par[8 * 64 + tid] = sp.kkr[1024 + c_];
        par[9 * 64 + tid] = sp.ln_gain[c_] * sp.out_gain[1536 + c_]; par[10 * 64 + tid] = sp.ln_bias[c_];
    }
#define PARV(k) (*(const LAS f32x4*)(par + (k) * 64 + j4))
    __syncthreads();
    f32x16 Hacc[2];
    {
        const int ln0 = lane & 31, hh0 = lane >> 5, cb0 = w & 1;
#pragma unroll
        for (int jb = 0; jb < 2; ++jb)
#pragma unroll
            for (int i = 0; i < 16; ++i) Hacc[jb][i] = (w >= 2 && w < 4 && (32 * jb + crow(i, hh0)) == (32 * cb0 + ln0)) ? 1.f : 0.f;
    }
    f32x4 n_cur, n_prv; u32x2 n_rc, n_kc, n_vc, n_rq, n_kq, n_vq;
#define SCAN_PREFETCH(tk, hasprev) do { const size_t tk_ = (tk); n_cur = *(const f32x4*)(sp.misc + tk_ * MISCP + j4); const bf16_t* rp_ = sp.P + tk_ * PP + 2048 + ch; \
        n_rc = *(const u32x2*)rp_; n_kc = *(const u32x2*)(rp_ + 512); n_vc = *(const u32x2*)(rp_ + 1024); \
        if (hasprev) { n_prv = *(const f32x4*)(sp.misc + (tk_ - 1) * MISCP + j4); n_rq = *(const u32x2*)(rp_ - PP); n_kq = *(const u32x2*)(rp_ - PP + 512); n_vq = *(const u32x2*)(rp_ - PP + 1024); } \
        else { n_prv = (f32x4){0.f, 0.f, 0.f, 0.f}; n_rq = (u32x2){0u, 0u}; n_kq = n_rq; n_vq = n_rq; } } while (0)
    SCAN_PREFETCH((size_t)(tok0 + seg * 1024 + tt), (seg * 1024 + tt) > 0);
    f32x4 r4, k4, v4, lw, kkn, kp, bb; float bon = 0.f;
    for (int ci = -1; ci < 32; ++ci) {
        f32x16 P1, P2;
        int lnv_ = lane; asm volatile("" : "+v"(lnv_)); const int ln = lnv_ & 31, hh = lnv_ >> 5;
        const float bon_c = bon; const int tokc_i = tok0 + seg * 1024 + ci * 32 + tt;
        if (ci >= 0) {
        __syncthreads();
        {
            const f32x4 r4 = *(const LAS f32x4*)(stash + tid * 12), v4 = *(const LAS f32x4*)(stash + tid * 12 + 4), kp = *(const LAS f32x4*)(stash + tid * 12 + 8);
            f32x4 cl = {0.f, 0.f, 0.f, 0.f};
            const int smax = 4 * w + 4;
#pragma unroll 4
            for (int s = 0; s < smax; ++s) { const f32x4 x = *(const LAS f32x4*)(lwS + s * 64 + j4); if (s <= tt) cl += x; }
            f32x4 ein, eex, einv;
#pragma unroll
            for (int e = 0; e < 4; ++e) { ein[e] = __expf(cl[e]); eex[e] = __expf(cl[e] - lw[e]); einv[e] = __expf(-cl[e]); }
            const f32x4 kkt = kkn * eex, rt = r4 * ein, kh = kp * einv, bh = bb * einv;
            u32x2 o;
            o.x = pk2(kkt[0], kkt[1]); o.y = pk2(kkt[2], kkt[3]); *(LAS u32x2*)(lds + O_KK + (tt * 72 + j4) * 2) = o;
            o.x = pk2(rt[0], rt[1]); o.y = pk2(rt[2], rt[3]); *(LAS u32x2*)(lds + O_R + (tt * 72 + j4) * 2) = o;
            o.x = pk2(kh[0], kh[1]); o.y = pk2(kh[2], kh[3]); *(LAS u32x2*)(lds + O_K + (tt * 72 + j4) * 2) = o;
            const unsigned k01 = o.x, k23 = o.y;
            o.x = pk2(bh[0], bh[1]); o.y = pk2(bh[2], bh[3]); *(LAS u32x2*)(lds + O_B + (tt * 72 + j4) * 2) = o;
            const unsigned nb01 = pk2(-bh[0], -bh[1]), nb23 = pk2(-bh[2], -bh[3]);
            const unsigned v01 = pk2(v4[0], v4[1]), v23 = pk2(v4[2], v4[3]);
            LAS unsigned short* kt = (LAS unsigned short*)(lds + O_KT) + j4 * 40 + tt;
            kt[0] = (unsigned short)(k01 & 0xffffu); kt[40] = (unsigned short)(k01 >> 16); kt[80] = (unsigned short)(k23 & 0xffffu); kt[120] = (unsigned short)(k23 >> 16);
            LAS unsigned short* bt = (LAS unsigned short*)(lds + O_BT) + j4 * 40 + tt;
            bt[0] = (unsigned short)(nb01 & 0xffffu); bt[40] = (unsigned short)(nb01 >> 16); bt[80] = (unsigned short)(nb23 & 0xffffu); bt[120] = (unsigned short)(nb23 >> 16);
            LAS unsigned short* vt = (LAS unsigned short*)(lds + O_VT) + j4 * 40 + tt;
            vt[0] = (unsigned short)(v01 & 0xffffu); vt[40] = (unsigned short)(v01 >> 16); vt[80] = (unsigned short)(v23 & 0xffffu); vt[120] = (unsigned short)(v23 >> 16);
            if (tt == 31) *(LAS f32x4*)(gam + j4) = ein;
        }
        __syncthreads();
        if (w < 4) {
#pragma unroll
            for (int i = 0; i < 16; ++i) { P1[i] = 0.f; P2[i] = 0.f; }
#pragma unroll
            for (int jb = 0; jb < 2; ++jb)
#pragma unroll
                for (int s = 0; s < 2; ++s) {
                    const bf16x8 hb = pack8(Hacc[jb], s);
                    const int off = (ln * 72 + 32 * jb + 16 * s + 4 * hh) * 2;
                    P1 = MFMA32(ld_krow(lds + O_KK + off), hb, P1);
                    P2 = MFMA32(ld_krow(lds + O_R + off), hb, P2);
                }
        } else {
            const int job = w - 4;
            const int oa = (job == 0 || job == 2) ? O_K : O_B, ob = (job < 2) ? O_KK : O_R;
            f32x16 Z;
#pragma unroll
            for (int i = 0; i < 16; ++i) Z[i] = 0.f;
#pragma unroll
            for (int ks = 0; ks < 4; ++ks) {
                const int off = (ln * 72 + ks * 16 + hh * 8) * 2;
                Z = MFMA32(*(const LAS bf16x8*)(lds + oa + off), *(const LAS bf16x8*)(lds + ob + off), Z);
            }
            if (job == 1) {
#pragma unroll
                for (int r = 0; r < 16; ++r) { const int c = crow(r, hh); NT[c * 32 + ln] = (c < ln) ? Z[r] : 0.f; }
                {
                    const bool lowrow = ln < 16;
                    u32x2 a_, b_;
                    a_.x = lowrow ? 0u : pk2(-Z[0], -Z[1]); a_.y = lowrow ? 0u : pk2(-Z[2], -Z[3]);
                    b_.x = lowrow ? 0u : pk2(-Z[4], -Z[5]); b_.y = lowrow ? 0u : pk2(-Z[6], -Z[7]);
                    *(LAS u32x2*)(lds + O_N21 + (ln * 40 + 4 * hh) * 2) = a_;
                    *(LAS u32x2*)(lds + O_N21 + (ln * 40 + 8 + 4 * hh) * 2) = b_;
                }
                asm volatile("s_waitcnt lgkmcnt(0)" ::: "memory");
                float Tr[16];
                const int tb = ln >> 4, tl = ln & 15;
                const LAS float* NTl = NT + tb * (16 * 32 + 16); asm volatile("" : "+v"(NTl));
                f32x4 nvc[4], nvn[4];
#pragma unroll
                for (int m = 0; m < 4; ++m) { nvc[m] = (f32x4){0.f, 0.f, 0.f, 0.f}; nvn[m] = nvc[m]; }
#pragma unroll
                for (int cc = 0; cc < 16; ++cc) {
                    const int cl = 15 - cc;
                    if (cl >= 1) {
#pragma unroll
                        for (int m = 0; m < 4; ++m) if (4 * m + 3 > cl - 1) nvn[m] = *(const LAS f32x4*)(NTl + (cl - 1) * 32 + 4 * m);
                    }
                    float s0 = (cl == tl) ? 1.f : 0.f, s1 = 0.f, s2 = 0.f, s3 = 0.f;
#pragma unroll
                    for (int m = 0; m < 4; ++m) {
                        if (4 * m + 3 > cl) {
                            if (4 * m + 0 > cl) s0 -= Tr[4 * m + 0] * nvc[m][0];
                            if (4 * m + 1 > cl) s1 -= Tr[4 * m + 1] * nvc[m][1];
                            if (4 * m + 2 > cl) s2 -= Tr[4 * m + 2] * nvc[m][2];
                            if (4 * m + 3 > cl) s3 -= Tr[4 * m + 3] * nvc[m][3];
                        }
                    }
                    Tr[cl] = (s0 + s1) + (s2 + s3);
                    asm volatile("" : "+v"(Tr[cl]) :: "memory");
#pragma unroll
                    for (int m = 0; m < 4; ++m) nvc[m] = nvn[m];
                }
                if (hh == 0) {
#pragma unroll
                    for (int q = 0; q < 4; ++q) {
                        const bool mine = (q >> 1) == tb; const int o8 = 8 * (q & 1);
                        u32x4 o; o.x = mine ? pk2(Tr[o8], Tr[o8 + 1]) : 0u; o.y = mine ? pk2(Tr[o8 + 2], Tr[o8 + 3]) : 0u; o.z = mine ? pk2(Tr[o8 + 4], Tr[o8 + 5]) : 0u; o.w = mine ? pk2(Tr[o8 + 6], Tr[o8 + 7]) : 0u;
                        *(LAS u32x4*)(lds + O_TM + ln * 80 + 16 * q) = o;
                    }
                }
            } else {
                const int oo = (job == 0) ? O_MK : (job == 2) ? O_NK : O_NB;
#pragma unroll
                for (int g = 0; g < 4; ++g) {
                    float z[4];
#pragma unroll
                    for (int e = 0; e < 4; ++e) {
                        const int s = 8 * g + 4 * hh + e;
                        const bool keep = (job == 0) ? (s < ln) : (s <= ln);
                        float v = keep ? Z[4 * g + e] : 0.f; if (job == 3) v = -v; z[e] = v;
                    }
                    u32x2 o; o.x = pk2(z[0], z[1]); o.y = pk2(z[2], z[3]);
                    *(LAS u32x2*)(lds + oo + (ln * 40 + 8 * g + 4 * hh) * 2) = o;
                }
            }
        }
        }
        if (ci + 1 < 32) {
        const int chunk = ci + 1;
        const int t0 = seg * 1024 + chunk * 32, t = t0 + tt; const size_t tok = (size_t)(tok0 + t);
        {
            const f32x4 cur = n_cur, prv = n_prv;
            f32x4 s = cur + (prv - cur) * PARV(3);
            if (jg < 8) {
#pragma unroll
                for (int e = 0; e < 4; ++e) s[e] = 1.0f - 2.0f * __builtin_amdgcn_rcpf(1.0f + __expf(2.0f * s[e]));
            }
            { u32x2 o_; o_.x = pk2(s[0], s[1]); o_.y = pk2(s[2], s[3]); *(LAS u32x2*)(lds + O_LORA + (tt * 72 + j4) * 2) = o_; }
        }
        {
            const u32x2 rc = n_rc, kc = n_kc, vc = n_vc, rq = n_rq, kq = n_kq, vq = n_vq;
            const f32x4 rcf = {bflo(rc.x), bfhi(rc.x), bflo(rc.y), bfhi(rc.y)}, rqf = {bflo(rq.x), bfhi(rq.x), bflo(rq.y), bfhi(rq.y)};
            const f32x4 kcf = {bflo(kc.x), bfhi(kc.x), bflo(kc.y), bfhi(kc.y)}, kqf = {bflo(kq.x), bfhi(kq.x), bflo(kq.y), bfhi(kq.y)};
            const f32x4 vcf = {bflo(vc.x), bfhi(vc.x), bflo(vc.y), bfhi(vc.y)}, vqf = {bflo(vq.x), bfhi(vq.x), bflo(vq.y), bfhi(vq.y)};
            r4 = rcf + (rqf - rcf) * PARV(0); k4 = kcf + (kqf - kcf) * PARV(1); v4 = vcf + (vqf - vcf) * PARV(2);
        }
        if (chunk + 1 < 32) SCAN_PREFETCH(tok + 32, 1);
        asm volatile("s_waitcnt lgkmcnt(0)" ::: "memory");
        bon = 0.f;
        {
            f32x4 wacc, aacc;
            {
                const int l5_ = lane & 31, h5_ = lane >> 5;
                const LAS unsigned char* arow = lds + O_LORA + ((4 * w + (l5_ & 3)) * 72 + h5_ * 8) * 2;
#pragma unroll
                for (int lo_ = 0; lo_ < 2; ++lo_)
#pragma unroll
                    for (int jb_ = 0; jb_ < 2; ++jb_) {
                        f32x16 D_;
#pragma unroll
                        for (int i = 0; i < 16; ++i) D_[i] = 0.f;
#pragma unroll
                        for (int ks = 0; ks < 2; ++ks)
                            D_ = MFMA32(*(const LAS bf16x8*)(arow + (lo_ * 32 + ks * 16) * 2), *(const LAS bf16x8*)(lds + O_WUP + lo_ * 5120 + ((32 * jb_ + l5_) * 40 + ks * 16 + h5_ * 8) * 2), D_);
                        if (h5_ == 0) {
                            LAS float* dst_ = (lo_ == 0 ? yb : qb) + (w * 4) * 64 + 32 * jb_ + l5_;
                            dst_[0] = D_[0]; dst_[64] = D_[1]; dst_[128] = D_[2]; dst_[192] = D_[3];
                        }
                    }
                asm volatile("s_waitcnt lgkmcnt(0)" ::: "memory");
                wacc = PARV(4) + *(const LAS f32x4*)(yb + (w * 4 + (lane >> 4)) * 64 + j4);
                aacc = PARV(5) + *(const LAS f32x4*)(qb + (w * 4 + (lane >> 4)) * 64 + j4);
            }
            float ssq = 0.f; f32x4 av;
#pragma unroll
            for (int e = 0; e < 4; ++e) {
                const float xw = -wacc[e]; const float spv = fmaxf(xw, 0.f) + __logf(1.0f + __expf(-fabsf(xw)));
                lw[e] = -__expf(-spv - 0.5f);
                av[e] = __builtin_amdgcn_rcpf(1.0f + __expf(-aacc[e]));
                kkn[e] = k4[e] * PARV(6)[e]; ssq += kkn[e] * kkn[e];
            }
            ssq = red16(ssq);
            const float inrm = __builtin_amdgcn_rsqf(fmaxf(ssq, 1e-24f));
#pragma unroll
            for (int e = 0; e < 4; ++e) {
                kkn[e] *= inrm; kp[e] = k4[e] * (1.0f + (av[e] - 1.0f) * PARV(7)[e]); bb[e] = kkn[e] * av[e];
                bon += r4[e] * kp[e] * PARV(8)[e];
            }
            bon = red16(bon);
            *(LAS f32x4*)(lwS + tt * 64 + j4) = lw;
            *(LAS f32x4*)(stash + tid * 12) = r4; *(LAS f32x4*)(stash + tid * 12 + 4) = v4; *(LAS f32x4*)(stash + tid * 12 + 8) = kp;
        }
        }
        if (ci >= 0) {
        __syncthreads();
        if (w < 4) {
            const bool isH = w < 2;
            const int icol = 32 * (w & 1) + ln;
            bf16x8 vfr[2];
            if (isH) {
#pragma unroll
                for (int ks = 0; ks < 2; ++ks) vfr[ks] = *(const LAS bf16x8*)(lds + O_VT + (icol * 40 + ks * 16 + hh * 8) * 2);
#pragma unroll
                for (int ks = 0; ks < 2; ++ks) {
                    P1 = MFMA32(*(const LAS bf16x8*)(lds + O_MK + (ln * 40 + ks * 16 + hh * 8) * 2), vfr[ks], P1);
                    P2 = MFMA32(*(const LAS bf16x8*)(lds + O_NK + (ln * 40 + ks * 16 + hh * 8) * 2), vfr[ks], P2);
                }
            }
            f32x16 Aa;
#pragma unroll
            for (int i = 0; i < 16; ++i) Aa[i] = 0.f;
#pragma unroll
            for (int s = 0; s < 1; ++s) Aa = MFMA32(ld_krow(lds + O_TM + (ln * 40 + 4 * hh) * 2), pack8(P1, 0), Aa);
            P1 = MFMA32(ld_krow(lds + O_N21 + (ln * 40 + 4 * hh) * 2), pack8(Aa, 0), P1);
            Aa = MFMA32(ld_krow(lds + O_TM + (ln * 40 + 16 + 4 * hh) * 2), pack8(P1, 1), Aa);
            bf16x8 ab[2]; ab[0] = pack8(Aa, 0); ab[1] = pack8(Aa, 1);
#pragma unroll
            for (int s = 0; s < 2; ++s) P2 = MFMA32(ld_krow(lds + O_NB + (ln * 40 + 16 * s + 4 * hh) * 2), ab[s], P2);
#pragma unroll
            for (int jb = 0; jb < 2; ++jb) {
                if (isH) {
#pragma unroll
                    for (int ks = 0; ks < 2; ++ks) Hacc[jb] = MFMA32(*(const LAS bf16x8*)(lds + O_KT + ((32 * jb + ln) * 40 + ks * 16 + hh * 8) * 2), vfr[ks], Hacc[jb]);
                }
#pragma unroll
                for (int s = 0; s < 2; ++s) Hacc[jb] = MFMA32(ld_krow(lds + O_BT + ((32 * jb + ln) * 40 + 16 * s + 4 * hh) * 2), ab[s], Hacc[jb]);
#pragma unroll
                for (int g = 0; g < 4; ++g) {
                    const f32x4 gv = *(const LAS f32x4*)(gam + 32 * jb + 8 * g + 4 * hh);
                    Hacc[jb][4 * g] *= gv[0]; Hacc[jb][4 * g + 1] *= gv[1]; Hacc[jb][4 * g + 2] *= gv[2]; Hacc[jb][4 * g + 3] *= gv[3];
                }
            }
            LAS float* ob = isH ? yb : qb;
#pragma unroll
            for (int r = 0; r < 16; ++r) ob[crow(r, hh) * 64 + icol] = P2[r];
        }
        __syncthreads();
        {
            const f32x4 y = *(const LAS f32x4*)(yb + tt * 64 + j4);
            const f32x4 q = *(const LAS f32x4*)(qb + tt * 64 + j4);
            u32x2 o; o.x = pk2(y[0], y[1]); o.y = pk2(y[2], y[3]);
            *(u32x2*)(sp.mixed + (size_t)tokc_i * 1024 + 512 + ch) = o;
            o.x = pk2(q[0], q[1]); o.y = pk2(q[2], q[3]);
            *(u32x2*)(sp.Q + (size_t)tokc_i * 512 + ch) = o;
            if (jg == 0) sp.bon[(size_t)tokc_i * 8 + h] = bon_c;
        }
        }
    }
    if (w < 4) {
        int le_ = lane; asm volatile("" : "+v"(le_));
        const int ln = le_ & 31, hh = le_ >> 5, icol = 32 * (w & 1) + ln;
        float* dst = ((w < 2) ? sp.HE : sp.PE) + (size_t)((b * 8 + h) * 4 + seg) * 4096;
#pragma unroll
        for (int jb = 0; jb < 2; ++jb)
#pragma unroll
            for (int r = 0; r < 16; ++r) dst[(32 * jb + crow(r, hh)) * 64 + icol] = Hacc[jb][r];
    }
#undef SCAN_PREFETCH
#undef PARV
}

__device__ __forceinline__ void scan_pass2(const ScanP& sp, int b, int h, int seg, LAS unsigned char* lds) {
    int tid_ = threadIdx.x; asm volatile("" : "+v"(tid_));
    const int tid = tid_, lane = tid & 63, w = __builtin_amdgcn_readfirstlane(tid >> 6);
    LAS float* Hc = (LAS float*)lds; LAS float* Hn = Hc + 4096;
    LAS unsigned char* HiT = lds + 32768;
    LAS float* par = (LAS float*)(lds + 32768 + 9216);
    LAS float* ybw = (LAS float*)(lds + 43008) + w * 2048;
    const int tok0 = b * SEQ;
    __syncthreads();
    if (tid < 64) { const int c_ = h * 64 + tid; par[tid] = sp.mu[1024 + c_]; par[64 + tid] = sp.ln_gain[c_] * sp.out_gain[1536 + c_]; par[128 + tid] = sp.ln_bias[c_]; }
    const int j = tid >> 3, i8 = (tid & 7) * 8;
    *(LAS f32x4*)(Hc + j * 64 + i8) = (f32x4){0.f, 0.f, 0.f, 0.f}; *(LAS f32x4*)(Hc + j * 64 + i8 + 4) = (f32x4){0.f, 0.f, 0.f, 0.f};
    __syncthreads();
    for (int s = 0; s < seg; ++s) {
        const float* HE = sp.HE + (size_t)((b * 8 + h) * 4 + s) * 4096; const float* PE = sp.PE + (size_t)((b * 8 + h) * 4 + s) * 4096;
        f32x4 a0 = *(const f32x4*)(HE + j * 64 + i8), a1 = *(const f32x4*)(HE + j * 64 + i8 + 4);
        f32x4 pvr[16];
#pragma unroll
        for (int jq = 0; jq < 16; ++jq) pvr[jq] = *(const f32x4*)(PE + j * 64 + 4 * jq);
#pragma unroll
        for (int jq = 0; jq < 16; ++jq) {
#pragma unroll
            for (int q = 0; q < 4; ++q) {
                const f32x4 h0 = *(const LAS f32x4*)(Hc + (4 * jq + q) * 64 + i8), h1 = *(const LAS f32x4*)(Hc + (4 * jq + q) * 64 + i8 + 4);
                a0 += h0 * pvr[jq][q]; a1 += h1 * pvr[jq][q];
            }
        }
        *(LAS f32x4*)(Hn + j * 64 + i8) = a0; *(LAS f32x4*)(Hn + j * 64 + i8 + 4) = a1;
        __syncthreads();
        LAS float* t_ = Hc; Hc = Hn; Hn = t_;
    }
    {
        const f32x4 h0 = *(const LAS f32x4*)(Hc + j * 64 + i8), h1 = *(const LAS f32x4*)(Hc + j * 64 + i8 + 4);
        const unsigned p0 = pk2(h0[0], h0[1]), p1 = pk2(h0[2], h0[3]), p2 = pk2(h1[0], h1[1]), p3 = pk2(h1[2], h1[3]);
        LAS unsigned short* d = (LAS unsigned short*)HiT + i8 * 72 + j;
        d[0] = (unsigned short)(p0 & 0xffffu); d[72] = (unsigned short)(p0 >> 16); d[144] = (unsigned short)(p1 & 0xffffu); d[216] = (unsigned short)(p1 >> 16);
        d[288] = (unsigned short)(p2 & 0xffffu); d[360] = (unsigned short)(p2 >> 16); d[432] = (unsigned short)(p3 & 0xffffu); d[504] = (unsigned short)(p3 >> 16);
    }
    __syncthreads();
    const int ln = lane & 31, hh = lane >> 5;
    for (int c = w; c < 32; c += 8) {
        const int t0 = seg * 1024 + c * 32;
#pragma unroll
        for (int ib = 0; ib < 2; ++ib) {
            f32x16 acc;
#pragma unroll
            for (int i = 0; i < 16; ++i) acc[i] = 0.f;
#pragma unroll
            for (int ks = 0; ks < 4; ++ks) {
                const bf16x8 qa = *(const bf16x8*)(sp.Q + (size_t)(tok0 + t0 + ln) * 512 + h * 64 + ks * 16 + hh * 8);
                const bf16x8 hb = *(const LAS bf16x8*)(HiT + ((ib * 32 + ln) * 72 + ks * 16 + hh * 8) * 2);
                acc = MFMA32(qa, hb, acc);
            }
#pragma unroll
            for (int r = 0; r < 16; ++r) ybw[crow(r, hh) * 64 + ib * 32 + ln] = acc[r];
        }
        asm volatile("s_waitcnt lgkmcnt(0)" ::: "memory");
#pragma unroll 4
        for (int it = 0; it < 8; ++it) {
            const int item = it * 64 + lane, tt = item >> 4, jg = item & 15, j4 = 4 * jg, ch = h * 64 + j4;
            const int t = t0 + tt; const size_t tok = (size_t)(tok0 + t);
            const u32x2 y0 = *(const u32x2*)(sp.mixed + tok * 1024 + 512 + ch);
            const f32x4 dy = *(const LAS f32x4*)(ybw + tt * 64 + j4);
            const f32x4 y = {bflo(y0.x) + dy[0], bfhi(y0.x) + dy[1], bflo(y0.y) + dy[2], bfhi(y0.y) + dy[3]};
            const float mean = red16((y[0] + y[1]) + (y[2] + y[3])) * (1.0f / 64.0f);
            const f32x4 dlt = y - mean;
            const float var = red16((dlt[0] * dlt[0] + dlt[1] * dlt[1]) + (dlt[2] * dlt[2] + dlt[3] * dlt[3])) * (1.0f / 64.0f);
            const float rs = __builtin_amdgcn_rsqf(var + 64e-5f);
            const bf16_t* vp = sp.P + tok * PP + 3072 + ch;
            const u32x2 vc = *(const u32x2*)vp; u32x2 vq = {0u, 0u}; if (t > 0) vq = *(const u32x2*)(vp - PP);
            const f32x4 vcf = {bflo(vc.x), bfhi(vc.x), bflo(vc.y), bfhi(vc.y)}, vqf = {bflo(vq.x), bfhi(vq.x), bflo(vq.y), bfhi(vq.y)};
            const f32x4 v4 = vcf + (vqf - vcf) * *(const LAS f32x4*)(par + j4);
            const float bon = sp.bon[tok * 8 + h];
            const u32x2 gr = *(const u32x2*)(sp.P + tok * PP + 3584 + ch);
            const f32x4 yo = dlt * rs * *(const LAS f32x4*)(par + 64 + j4) + *(const LAS f32x4*)(par + 128 + j4) + v4 * bon;
            u32x2 o; o.x = pk2(yo[0] * silu(bflo(gr.x)), yo[1] * silu(bfhi(gr.x))); o.y = pk2(yo[2] * silu(bflo(gr.y)), yo[3] * silu(bfhi(gr.y)));
            *(u32x2*)(sp.mixed + tok * 1024 + 512 + ch) = o;
        }
        asm volatile("s_waitcnt lgkmcnt(0)" ::: "memory");
    }
}

__device__ __forceinline__ int next_item(unsigned* ctr, LAS unsigned* slot) {
    __syncthreads();
    if (threadIdx.x == 0) *slot = atomicAdd(ctr, 1u);
    __syncthreads();
    return (int)*slot;
}

__device__ __forceinline__ void xbar(unsigned* ctl, unsigned k, unsigned x, unsigned nloc, unsigned nx) {
    asm volatile("s_waitcnt vmcnt(0)" ::: "memory");
    __syncthreads();
    if (threadIdx.x == 0) {
        const unsigned old = __hip_atomic_fetch_add(ctl + 2048 + 64 * x, 1u, __ATOMIC_RELAXED, __HIP_MEMORY_SCOPE_AGENT);
        if (old + 1u == nloc * (k + 1u)) {
            __builtin_amdgcn_fence(__ATOMIC_RELEASE, "agent");
            __hip_atomic_fetch_add(ctl + 3072, 1u, __ATOMIC_RELAXED, __HIP_MEMORY_SCOPE_AGENT);
        }
        const unsigned target = nx * (k + 1u);
        while (__hip_atomic_load(ctl + 3072, __ATOMIC_RELAXED, __HIP_MEMORY_SCOPE_AGENT) < target) __builtin_amdgcn_s_sleep(1);
    }
    __syncthreads();
    __builtin_amdgcn_fence(__ATOMIC_ACQUIRE, "agent");
    asm volatile("s_waitcnt vmcnt(0)" ::: "memory");
}

__global__ void __launch_bounds__(512) hymba_fwd(Args a) {
    extern __shared__ __attribute__((aligned(16))) unsigned char lds_raw[];
    LAS unsigned char* lds = (LAS unsigned char*)lds_raw;
    LAS unsigned* qslot = (LAS unsigned*)(lds + QSLOT_OFF);
#define WSPTRS unsigned char* ws_ = a.ws; asm volatile("" : "+s"(ws_)); unsigned* ctl = (unsigned*)(ws_ + WS_CTL); bf16_t* WtIn = (bf16_t*)(ws_ + WS_WIN); bf16_t* WtOut = (bf16_t*)(ws_ + WS_WOUT); \
    bf16_t* hb = (bf16_t*)(ws_ + WS_HB); bf16_t* proj = (bf16_t*)(ws_ + WS_PROJ); float* misc = (float*)(ws_ + WS_MISC); \
    bf16_t* mixed = (bf16_t*)(ws_ + WS_MIXED); float* hss = (float*)(ws_ + WS_HSS); const float* biasT = (const float*)(ws_ + WS_BIAS); float* outp = a.out; asm volatile("" : "+s"(outp)); \
    (void)ctl; (void)WtIn; (void)WtOut; (void)hb; (void)proj; (void)misc; (void)mixed; (void)hss; (void)biasT; (void)outp;
    const int lo = a.ph_lo, hi = a.ph_hi;
#define IN(k) (lo <= (k) && (k) < hi)
    unsigned nloc = 1, nxcd = 1;
    const unsigned xcc = (unsigned)__builtin_amdgcn_s_getreg((3 << 11) | 20) & 0xFu;
    if (threadIdx.x == 0) __hip_atomic_fetch_add((unsigned*)(a.ws + WS_CTL) + 1024 + 64 * xcc, 1u, __ATOMIC_RELAXED, __HIP_MEMORY_SCOPE_AGENT);
#define SEAM(k, bi) do { if (IN(k) && IN((k) + 1)) { if ((k) == 0) { cg::this_grid().sync(); \
            { unsigned* c_ = (unsigned*)(a.ws + WS_CTL) + 1024; nloc = (unsigned)__builtin_amdgcn_readfirstlane((int)__hip_atomic_load(c_ + 64 * xcc, __ATOMIC_RELAXED, __HIP_MEMORY_SCOPE_AGENT)); unsigned nx_ = 0; \
                for (int q_ = 0; q_ < 16; ++q_) nx_ += (__hip_atomic_load(c_ + 64 * q_, __ATOMIC_RELAXED, __HIP_MEMORY_SCOPE_AGENT) != 0u) ? 1u : 0u; nxcd = (unsigned)__builtin_amdgcn_readfirstlane((int)nx_); } } \
        else xbar((unsigned*)(a.ws + WS_CTL), (unsigned)(bi), xcc, nloc, nxcd); } } while (0)
    if (IN(0)) { prologue(a, lds); }
    SEAM(0, 0);
#pragma unroll 1
    for (int l = 0; l < 2; ++l) {
        const int pb = 1 + 5 * l;
        if (IN(pb)) for (int rep = 0; rep < REP1A; ++rep) {
            WSPTRS
            if (rep) cg::this_grid().sync();
            pg8::Gemm g{hb, WtIn + (size_t)l * NINP * 1024, NTOK, NCD, 1024}; pg8::StaticOrder S; S.init(NTOK, NCD, gridDim.x, (int)blockIdx.x);
            pg8::EpiIn E{proj, misc, hss, 16};
            pg8::gemm_phase<pg8::EpiIn, pg8::StaticOrder, true, true>(lds, g, S, E);
        }
        SEAM(pb, 6 * l + 0);
        if (IN(pb + 1)) {
            WSPTRS
            ScanP sp{proj, mixed, misc, a.rwkv_mu + l * 1600, a.rwkv_w_up + l * 32 * 512, a.rwkv_w0 + l * 512, a.rwkv_a_up + l * 32 * 512, a.rwkv_a0 + l * 512,
                     a.rwkv_kkr + l * 3 * 512, a.rwkv_ln_gain + l * 512, a.rwkv_ln_bias + l * 512, a.out_gain + l * 2048,
                     (bf16_t*)(ws_ + WS_Q), (float*)(ws_ + WS_BON), (float*)(ws_ + WS_HE), (float*)(ws_ + WS_PE)};
            AttnP ap{proj, mixed, misc, a.qk_gain + l * 256, a.out_gain + l * 2048, biasT, a.forget_bias + l * 8, 0.f, 0.f};
            for (;;) {
                const int idx = next_item(ctl + pb + 1, qslot);
                if (idx >= 256 + 1024) break;
                if (idx < 256) {
#ifndef DIS_S
                    scan_pass1(sp, idx >> 5, (idx >> 2) & 7, idx & 3, lds);
#endif
                } else {
                    const int ci = idx - 256, qb = 15 - (ci >> 6), bh = ci & 63;
#ifndef DIS_C
                    attn_item<2>(ap, bh >> 3, bh & 7, qb, lds);
#endif
                }
            }
            xbar(ctl, (unsigned)(6 * l + 1), xcc, nloc, nxcd);
            for (;;) {
                const int idx = next_item(ctl + 32 + pb + 1, qslot);
                if (idx >= 256) break;
                if (idx < 256) {
#ifndef DIS_S
                    scan_pass2(sp, idx >> 5, (idx >> 2) & 7, idx & 3, lds);
#endif
                } else {
                    const int ci = 768 + idx - 256, qb = 15 - (ci >> 6), bh = ci & 63;
#ifndef DIS_C
                    attn_item<2>(ap, bh >> 3, bh & 7, qb, lds);
#endif
                }
            }
        }
        SEAM(pb + 1, 6 * l + 2);
        if (IN(pb + 2)) {
            WSPTRS
            {
                pg8::Gemm g{hb, WtIn + (size_t)l * NINP * 1024 + (size_t)NCD * 1024, NTOK, 4096, 1024}; pg8::StaticOrder S; S.init(NTOK, 4096, gridDim.x, (int)blockIdx.x);
                pg8::EpiIn E{proj, misc, hss, 16};
                pg8::gemm_phase<pg8::EpiIn, pg8::StaticOrder, true, true>(lds, g, S, E);
            }
            {
                pg8::Gemm g{mixed, WtOut + (size_t)(2 * l) * 1024 * 1024, NTOK, 1024, 1024}; pg8::StaticOrder S; S.init(NTOK, 1024, gridDim.x, (int)blockIdx.x);
                pg8::EpiOut E{l == 0 ? a.x : outp, outp, hb, hss, 0};
                pg8::gemm_phase<pg8::EpiOut, pg8::StaticOrder, true, true>(lds, g, S, E);
            }
        }
        SEAM(pb + 2, 6 * l + 3);
        if (IN(pb + 3)) for (int rep = 0; rep < REP2B; ++rep) {
            WSPTRS
            if (rep) cg::this_grid().sync();
            float lam;
            {
                const float* dl = a.diff_lambda + l * 256; int tl_ = threadIdx.x; asm volatile("" : "+v"(tl_)); const int lane = tl_ & 63;
                const float s1 = wave_sum(dl[lane] * dl[64 + lane]), s2 = wave_sum(dl[128 + lane] * dl[192 + lane]);
                const float lam_init = 0.8f - 0.6f * expf(-0.3f * (float)l);
                lam = expf(s1) - expf(s2) + lam_init;
                const float lam_u = __int_as_float(__builtin_amdgcn_readfirstlane(__float_as_int(lam))), oml_u = __int_as_float(__builtin_amdgcn_readfirstlane(__float_as_int(1.0f - lam_init)));
                AttnP ap{proj, mixed, misc, a.qk_gain + l * 256, a.out_gain + l * 2048, biasT, a.forget_bias + l * 8, lam_u, oml_u};
                for (;;) {
                    const int idx = next_item(ctl + pb + 3 + 16 * rep, qslot);
                    if (idx >= 1536) break;
                    if (idx < 512) { const int qb = 15 - (idx >> 5), bh = idx & 31;
#ifndef DIS_A
 attn_item<0>(ap, bh >> 2, bh & 3, qb, lds);
#endif
 }
                    else { const int i2 = idx - 512, qb = 15 - (i2 >> 6), bh = i2 & 63;
#ifndef DIS_B
 attn_item<1>(ap, bh >> 3, bh & 7, qb, lds);
#endif
 }
                }
            }
        }
        SEAM(pb + 3, 6 * l + 4);
        if (IN(pb + 4)) {
            WSPTRS
            pg8::Gemm g{mixed, WtOut + (size_t)(2 * l + 1) * 1024 * 1024, NTOK, 1024, 1024}; pg8::StaticOrder S; S.init(NTOK, 1024, gridDim.x, (int)blockIdx.x);
            pg8::EpiOut E{outp, outp, hb, hss, l == 0 ? 1 : 0};
            pg8::gemm_phase<pg8::EpiOut, pg8::StaticOrder, true, true>(lds, g, S, E);
        }
        if (l == 0) SEAM(pb + 4, 6 * l + 5);
    }
#undef IN
#undef SEAM
}

extern "C" void kernel_launch(void* const* d_in, const int* in_sizes, int n_in, void* d_out, int out_size, void* d_ws, size_t ws_size, hipStream_t stream) {
    static int grid = 0;
    if (grid == 0) {
        if (n_in != 17 || ws_size < WS_END) { fprintf(stderr, "kernel_launch: unexpected inputs (n_in %d, ws %zu < %zu)\n", n_in, ws_size, (size_t)WS_END); grid = -1; return; }
        int dev = 0, cus = 0, per_cu = 0;
        hipGetDevice(&dev); hipDeviceGetAttribute(&cus, hipDeviceAttributeMultiprocessorCount, dev);
        if (hipFuncSetAttribute((const void*)hymba_fwd, hipFuncAttributeMaxDynamicSharedMemorySize, LDS_BYTES) != hipSuccess) { fprintf(stderr, "kernel_launch: hipFuncSetAttribute failed\n"); grid = -1; return; }
        hipOccupancyMaxActiveBlocksPerMultiprocessor(&per_cu, (const void*)hymba_fwd, 512, LDS_BYTES);
        if (per_cu < 1) per_cu = 1;
        (void)hipGetLastError();
        grid = cus * 1;
        if (grid > 256) grid = 256;
    }
    if (grid < 0) return;
    hipMemsetAsync((char*)d_ws + WS_CTL, 0, 16384, stream);
    Args a{};
    a.x = (const float*)d_in[0]; a.norm_gain = (const float*)d_in[1]; a.w_in = (const float*)d_in[2]; a.w_out = (const float*)d_in[3]; a.rel_bias = (const float*)d_in[4];
    a.qk_gain = (const float*)d_in[5]; a.diff_lambda = (const float*)d_in[6]; a.forget_bias = (const float*)d_in[7]; a.out_gain = (const float*)d_in[8]; a.rwkv_mu = (const float*)d_in[9];
    a.rwkv_w_up = (const float*)d_in[10]; a.rwkv_w0 = (const float*)d_in[11]; a.rwkv_a_up = (const float*)d_in[12]; a.rwkv_a0 = (const float*)d_in[13]; a.rwkv_kkr = (const float*)d_in[14];
    a.rwkv_ln_gain = (const float*)d_in[15]; a.rwkv_ln_bias = (const float*)d_in[16];
    a.out = (float*)d_out; a.ws = (unsigned char*)d_ws;
#if MK_PER_PHASE
    for (int ph = 0; ph < 11; ++ph) { a.ph_lo = ph; a.ph_hi = ph + 1; hipLaunchKernelGGL(hymba_fwd, dim3(grid), dim3(512), LDS_BYTES, stream, a); }
#else
    a.ph_lo = 0; a.ph_hi = 11;
    void* args[] = {&a};
    hipError_t e = hipLaunchCooperativeKernel((const void*)hymba_fwd, dim3(grid), dim3(512), args, LDS_BYTES, stream);
    if (e != hipSuccess) fprintf(stderr, "cooperative launch failed: %s (grid %d)\n", hipGetErrorString(e), grid);
#endif
}
```

```cpp
#include <hip/hip_runtime.h>
#include <hip/hip_cooperative_groups.h>
#include <cstdio>
#include <cstdint>
namespace cg = cooperative_groups;

#ifndef MK_PER_PHASE
#define MK_PER_PHASE 0
#endif

#ifndef REP1A
#define REP1A 1
#endif
#ifndef REP2A
#define REP2A 1
#endif
#ifndef REP2B
#define REP2B 1
#endif
namespace pg8 {
#define PG8_LAS __attribute__((address_space(3)))
typedef unsigned short bf16_t;
typedef short bf16x8 __attribute__((ext_vector_type(8)));
typedef float f32x4 __attribute__((ext_vector_type(4)));
typedef unsigned u32x4 __attribute__((ext_vector_type(4)));
constexpr int BM = 256, BK = 64, HALF = 128, HTB = HALF * BK * 2  , STAGE_BYTES = 8 * HTB, NXCD = 8, WGM = 8;

__host__ __device__ __forceinline__ int lds_byte(int r, int c) { const int st = (r >> 4) * 2 + (c >> 5), rr = r & 15, cc = c & 31, ob = rr * 64 + cc * 2; return st * 1024 + (ob ^ (((ob >> 9) & 1) << 5)); }
__host__ __device__ __forceinline__ void stage_rc(int b, int& R, int& C) { const int st = b / 1024, sb = b % 1024, swz = sb ^ (((sb >> 9) & 1) << 5); R = (st >> 1) * 16 + swz / 64; C = (st & 1) * 32 + (swz % 64) / 2; }
__host__ __device__ __forceinline__ int perm32(int rho) { const int n = rho >> 4, i = rho & 15; return 8 * (i >> 2) + 4 * n + (i & 3); }

struct Unit { int pm, pn; };
struct Gemm { const bf16_t* A; const bf16_t* Bt; int M, N, K; };

struct StaticOrder {
    int nM, nN, nwg, G, c;
    __host__ __device__ void init(int M, int N, int G_, int c_) { nM = M / BM; nN = N / BM; nwg = nM * nN; G = G_; c = c_; }
    __host__ __device__ bool next(int i, Unit& u) const {
        const long L = (long)i * G + c; if (L >= nwg) return false;
        int wgid = (int)L; { const int q = nwg / NXCD, r = nwg % NXCD, xcd = wgid % NXCD, off = wgid / NXCD; wgid = (xcd < r ? xcd * (q + 1) : r * (q + 1) + (xcd - r) * q) + off; }
        const int nig = WGM * nN, gid = wgid / nig, fm = gid * WGM, gsz = (nM - fm) < WGM ? (nM - fm) : WGM;
        u.pm = fm + ((wgid % nig) % gsz); u.pn = (wgid % nig) / gsz; return true;
    }
    __device__ __forceinline__ void a_ready(const Unit&) const {}
    __device__ __forceinline__ void done(const Unit&) const {}
};

__device__ __forceinline__ unsigned cvt_pk_bf16(float lo, float hi) { unsigned r; asm volatile("v_cvt_pk_bf16_f32 %0, %1, %2" : "=v"(r) : "v"(lo), "v"(hi)); return r; }
typedef float f32x2 __attribute__((ext_vector_type(2)));

typedef unsigned u32x2 __attribute__((ext_vector_type(2)));
struct EpiIn {
    static constexpr bool PERM = true, AFTER_DRAIN = false;
    bf16_t* P; float* misc; const float* hss; int ntile_main;
    __device__ __forceinline__ void operator()(const f32x4 (&acc)[2][2][4][2], const Unit& u, int wr, int wc, int fr, int fq) const {
        const int row0 = u.pm * BM + wr * 64 + fr;
        float rsv[2][4];
#pragma unroll
        for (int ai = 0; ai < 2; ++ai) {
#pragma unroll
            for (int m = 0; m < 4; ++m) {
                const int row = row0 + ai * HALF + m * 16;
                const f32x4 h0 = *((const f32x4*)(hss + (size_t)row * 16) + fq);
                float ss = (h0[0] + h0[1]) + (h0[2] + h0[3]);
                ss += __shfl_xor(ss, 16); ss += __shfl_xor(ss, 32);
                rsv[ai][m] = 1.0f / sqrtf(ss * (1.0f / 1024.0f) + 1e-6f);
            }
            asm volatile("" ::: "memory");
        }
#pragma unroll
        for (int ai = 0; ai < 2; ++ai)
#pragma unroll
            for (int m = 0; m < 4; ++m) {
                const int row = row0 + ai * HALF + m * 16;
                const float rs = rsv[ai][m];
                if (u.pn < ntile_main) {
                    bf16_t* rowp = P + (size_t)row * 4160 + u.pn * BM + wc * 32 + 8 * fq;
#pragma unroll
                    for (int bj = 0; bj < 2; ++bj) {
                        const f32x4 v0 = acc[ai][bj][m][0] * rs, v1 = acc[ai][bj][m][1] * rs;
                        u32x4 w; w.x = cvt_pk_bf16(v0[0], v0[1]); w.y = cvt_pk_bf16(v0[2], v0[3]); w.z = cvt_pk_bf16(v1[0], v1[1]); w.w = cvt_pk_bf16(v1[2], v1[3]);
                        *(u32x4*)(rowp + bj * HALF) = w;
                    }
                } else {
                    const int c0 = wc * 32 + 8 * fq;
                    if (c0 < 72) {
                        *(f32x4*)(misc + (size_t)row * 80 + c0) = acc[ai][0][m][0] * rs;
                        *(f32x4*)(misc + (size_t)row * 80 + c0 + 4) = acc[ai][0][m][1] * rs;
                    }
                }
                asm volatile("" ::: "memory");
            }
    }
};
struct EpiOut {
    static constexpr bool PERM = false, AFTER_DRAIN = false;
    const float* res; float* out; bf16_t* hb; float* hss; int write_hb;
    __device__ __forceinline__ void operator()(const f32x4 (&acc)[2][2][4][2], const Unit& u, int wr, int wc, int fr, int fq) const {
        const int col0 = u.pn * BM + wc * 32 + 4 * fq;
#pragma unroll
        for (int ai = 0; ai < 2; ++ai)
#pragma unroll
            for (int m = 0; m < 4; ++m) {
                const int row = u.pm * BM + ai * HALF + wr * 64 + m * 16 + fr;
                const size_t off = (size_t)row * 1024 + col0;
                float ss = 0.f;
#pragma unroll
                for (int bj = 0; bj < 2; ++bj)
#pragma unroll
                    for (int n = 0; n < 2; ++n) {
                        const f32x4 o = *(const f32x4*)(res + off + bj * HALF + n * 16) + acc[ai][bj][m][n];
                        *(f32x4*)(out + off + bj * HALF + n * 16) = o;
                        if (write_hb) {
                            u32x2 w; w.x = cvt_pk_bf16(o[0], o[1]); w.y = cvt_pk_bf16(o[2], o[3]);
                            *(u32x2*)(hb + off + bj * HALF + n * 16) = w;
                            ss += (o[0] * o[0] + o[1] * o[1]) + (o[2] * o[2] + o[3] * o[3]);
                        }
                    }
                if (write_hb) {
                    ss += __shfl_xor(ss, 16); ss += __shfl_xor(ss, 32);
                    if (fq == 0) hss[(size_t)row * 16 + u.pn * 4 + wc] = ss;
                }
                if (m & 1) asm volatile("" ::: "memory");
            }
    }
};

template <class Epi, class Sched, bool ALIGN_EPI = false, bool SP2 = false>
__device__ __forceinline__ void gemm_phase(PG8_LAS unsigned char* lds, const Gemm g, const Sched& S, const Epi& E) {
    int tid_ = threadIdx.x; asm volatile("" : "+v"(tid_));
    const int tid = tid_, wid = __builtin_amdgcn_readfirstlane(tid >> 6), lane = tid & 63, wr = wid >> 2, wc = wid & 3, fr = lane & 15, fq = lane >> 4;
    const int K = g.K, nt = K / BK;
    unsigned voffA[2], voffB[2];
#pragma unroll
    for (int i = 0; i < 2; ++i) { int R, C; stage_rc(tid * 16 + i * 8192, R, C); const int Rb = Epi::PERM ? ((R & ~31) + perm32(R & 31)) : R;
        voffA[i] = (unsigned)(R * K + C) * 2u; voffB[i] = (unsigned)(Rb * K + C) * 2u; }
    const size_t kstep = (size_t)(BK * 2);
    const size_t hstep = (size_t)HALF * K * 2;
    const size_t tstep = 2 * hstep;
    const unsigned ldsw = (unsigned)wid * 1024u;
    const int aoff = lds_byte(wr * 64 + fr, fq * 8), boff = lds_byte(wc * 32 + fr, fq * 8);
#define PG8_SA(b, h) (((b) * 2 + (h)) * HTB)
#define PG8_SB(b, h) ((4 + (b) * 2 + (h)) * HTB)
#define PG8_STAGE(bufoff, gbase, voff) do { _Pragma("unroll") for (int _i = 0; _i < 2; ++_i) \
        __builtin_amdgcn_global_load_lds((const unsigned*)((const char*)(gbase) + (voff)[_i]), (PG8_LAS unsigned*)(lds + (bufoff) + ldsw + _i * 8192), 16, 0, 0); } while (0)
#define PG8_LDA(dst, b, h) do { _Pragma("unroll") for (int m = 0; m < 4; ++m) _Pragma("unroll") for (int k = 0; k < 2; ++k) dst[m][k] = *(const PG8_LAS bf16x8*)(lds + PG8_SA(b, h) + aoff + m * 2048 + k * 1024); } while (0)
#define PG8_LDB(dst, b, h) do { _Pragma("unroll") for (int n = 0; n < 2; ++n) _Pragma("unroll") for (int k = 0; k < 2; ++k) dst[n][k] = *(const PG8_LAS bf16x8*)(lds + PG8_SB(b, h) + boff + n * 2048 + k * 1024); } while (0)
#define PG8_MMA(ai, bj, At, Bt) do { __builtin_amdgcn_s_setprio(1); _Pragma("unroll") for (int m = 0; m < 4; ++m) _Pragma("unroll") for (int n = 0; n < 2; ++n) _Pragma("unroll") for (int k = 0; k < 2; ++k) \
        acc[ai][bj][m][n] = __builtin_amdgcn_mfma_f32_16x16x32_bf16(Bt[n][k], At[m][k], acc[ai][bj][m][n], 0, 0, 0); __builtin_amdgcn_s_setprio(0); } while (0)
#define PG8_WAIT_V(n) asm volatile("s_waitcnt vmcnt(" #n ")" ::: "memory")
#define PG8_WAIT_L(n) asm volatile("s_waitcnt lgkmcnt(" #n ")" ::: "memory")
#define PG8_BAR __builtin_amdgcn_s_barrier()
#define PG8_SCHED __builtin_amdgcn_sched_barrier(0)
    Unit cur, nxt; int ui = 0;
    if (!S.next(0, cur)) return;
    f32x4 acc[2][2][4][2];
#pragma unroll
    for (int a = 0; a < 2; ++a)
#pragma unroll
        for (int b = 0; b < 2; ++b)
#pragma unroll
            for (int m = 0; m < 4; ++m)
#pragma unroll
                for (int n = 0; n < 2; ++n) acc[a][b][m][n] = (f32x4){0.f, 0.f, 0.f, 0.f};
    bf16x8 At[4][2], B0[2][2], B1[2][2];
    const char* cA = (const char*)g.A + (size_t)cur.pm * tstep; const char* cB = (const char*)g.Bt + (size_t)cur.pn * tstep;
    S.a_ready(cur);
    if constexpr (SP2) {
        PG8_STAGE(PG8_SB(0, 0), cB, voffB); PG8_STAGE(PG8_SB(0, 1), cB + hstep, voffB); PG8_STAGE(PG8_SA(0, 0), cA, voffA); PG8_STAGE(PG8_SA(0, 1), cA + hstep, voffA);
        if (wr == 1) PG8_BAR;
        PG8_WAIT_V(2); PG8_BAR;
        PG8_STAGE(PG8_SB(1, 0), cB + kstep, voffB); PG8_STAGE(PG8_SA(1, 0), cA + kstep, voffA); PG8_STAGE(PG8_SB(1, 1), cB + hstep + kstep, voffB);
        PG8_WAIT_V(6); PG8_BAR;
    } else {
        PG8_STAGE(PG8_SB(0, 0), cB, voffB); PG8_STAGE(PG8_SA(0, 0), cA, voffA); PG8_STAGE(PG8_SB(0, 1), cB + hstep, voffB); PG8_STAGE(PG8_SA(0, 1), cA + hstep, voffA);
        if (wr == 1) PG8_BAR;
        PG8_WAIT_V(4); PG8_BAR;
        PG8_STAGE(PG8_SB(1, 0), cB + kstep, voffB); PG8_STAGE(PG8_SA(1, 0), cA + kstep, voffA); PG8_STAGE(PG8_SB(1, 1), cB + hstep + kstep, voffB);
        PG8_WAIT_V(6); PG8_BAR;
    }
    for (;;) {
        const bool has_next = S.next(ui + 1, nxt);
        const char* nA = has_next ? (const char*)g.A + (size_t)nxt.pm * tstep : cA; const char* nB = has_next ? (const char*)g.Bt + (size_t)nxt.pn * tstep : cB;
        for (int t = 0; t < nt; t += 2) {
            const bool last = (t == nt - 2);
            const char* a1 = cA + (size_t)(t + 1) * kstep;
            const char* a2 = last ? nA : cA + (size_t)(t + 2) * kstep; const char* b2 = last ? nB : cB + (size_t)(t + 2) * kstep;
            const char* a3 = a2 + kstep; const char* b3 = b2 + kstep;
            if (last && has_next) S.a_ready(nxt);
            if constexpr (SP2) {
            PG8_LDB(B0, 0, 0); PG8_LDB(B1, 0, 1); PG8_SCHED; PG8_LDA(At, 0, 0); PG8_STAGE(PG8_SA(1, 1), a1 + hstep, voffA);
            PG8_WAIT_V(8); PG8_WAIT_L(0); PG8_BAR; PG8_MMA(0, 0, At, B0); PG8_MMA(0, 1, At, B1); PG8_BAR; PG8_SCHED;
            PG8_LDA(At, 0, 1); PG8_STAGE(PG8_SB(0, 0), b2, voffB); PG8_STAGE(PG8_SB(0, 1), b2 + hstep, voffB); PG8_STAGE(PG8_SA(0, 0), a2, voffA);
            PG8_WAIT_V(8); PG8_WAIT_L(0); PG8_BAR; PG8_MMA(1, 0, At, B0); PG8_MMA(1, 1, At, B1); PG8_BAR; PG8_SCHED;
            PG8_LDB(B0, 1, 0); PG8_LDB(B1, 1, 1); PG8_SCHED; PG8_LDA(At, 1, 0); PG8_STAGE(PG8_SA(0, 1), a2 + hstep, voffA);
            PG8_WAIT_V(8); PG8_WAIT_L(0); PG8_BAR; PG8_MMA(0, 0, At, B0); PG8_MMA(0, 1, At, B1); PG8_BAR; PG8_SCHED;
            PG8_LDA(At, 1, 1); PG8_STAGE(PG8_SB(1, 0), b3, voffB); PG8_STAGE(PG8_SB(1, 1), b3 + hstep, voffB); PG8_STAGE(PG8_SA(1, 0), a3, voffA);
            PG8_WAIT_V(8); PG8_WAIT_L(0); PG8_BAR; PG8_MMA(1, 0, At, B0); PG8_MMA(1, 1, At, B1); PG8_BAR; PG8_SCHED;
            } else {
            PG8_LDB(B0, 0, 0); PG8_SCHED; PG8_LDA(At, 0, 0); PG8_STAGE(PG8_SA(1, 1), a1 + hstep, voffA);
            PG8_WAIT_L(8); PG8_BAR; PG8_WAIT_L(0); PG8_MMA(0, 0, At, B0); PG8_BAR; PG8_SCHED;
            PG8_LDB(B1, 0, 1); PG8_STAGE(PG8_SB(0, 0), b2, voffB);
            PG8_BAR; PG8_WAIT_L(0); PG8_MMA(0, 1, At, B1); PG8_BAR;
            PG8_LDA(At, 0, 1); PG8_STAGE(PG8_SA(0, 0), a2, voffA);
            PG8_BAR; PG8_WAIT_L(0); PG8_MMA(1, 0, At, B0); PG8_BAR; PG8_SCHED;
            PG8_STAGE(PG8_SB(0, 1), b2 + hstep, voffB);
            PG8_WAIT_V(6); PG8_BAR; PG8_MMA(1, 1, At, B1); PG8_BAR;
            PG8_LDB(B0, 1, 0); PG8_SCHED; PG8_LDA(At, 1, 0); PG8_STAGE(PG8_SA(0, 1), a2 + hstep, voffA);
            PG8_WAIT_L(8); PG8_BAR; PG8_WAIT_L(0); PG8_MMA(0, 0, At, B0); PG8_BAR; PG8_SCHED;
            PG8_LDB(B1, 1, 1); PG8_STAGE(PG8_SB(1, 0), b3, voffB);
            PG8_BAR; PG8_WAIT_L(0); PG8_MMA(0, 1, At, B1); PG8_BAR;
            PG8_LDA(At, 1, 1); PG8_STAGE(PG8_SA(1, 0), a3, voffA);
            PG8_BAR; PG8_WAIT_L(0); PG8_MMA(1, 0, At, B0); PG8_BAR; PG8_SCHED;
            PG8_STAGE(PG8_SB(1, 1), b3 + hstep, voffB);
            PG8_WAIT_V(6); PG8_BAR; PG8_MMA(1, 1, At, B1); PG8_BAR;
            }
        }
        if constexpr (ALIGN_EPI) { if (wr == 0) PG8_BAR; }
        if constexpr (!Epi::AFTER_DRAIN) { E(acc, cur, wr, wc, fr, fq); S.done(cur); }
        if (!has_next) break;
#pragma unroll
        for (int a = 0; a < 2; ++a)
#pragma unroll
            for (int b = 0; b < 2; ++b)
#pragma unroll
                for (int m = 0; m < 4; ++m)
#pragma unroll
                    for (int n = 0; n < 2; ++n) acc[a][b][m][n] = (f32x4){0.f, 0.f, 0.f, 0.f};
        cur = nxt; cA = nA; cB = nB; ++ui;
        if constexpr (ALIGN_EPI) { if (wr == 1) PG8_BAR; }
    }
    PG8_WAIT_V(0);
    if constexpr (!ALIGN_EPI) { if (wr == 0) PG8_BAR; }
    PG8_BAR;
    if constexpr (Epi::AFTER_DRAIN) { E.fused(acc, cur, wr, wc, fr, fq, lds, wid, lane); S.done(cur); }
#undef PG8_SA
#undef PG8_SB
#undef PG8_STAGE
#undef PG8_LDA
#undef PG8_LDB
#undef PG8_MMA
#undef PG8_WAIT_V
#undef PG8_WAIT_L
#undef PG8_BAR
#undef PG8_SCHED
}
}

#define LAS __attribute__((address_space(3)))
typedef unsigned short bf16_t;
typedef short bf16x8 __attribute__((ext_vector_type(8)));
typedef short s16x4 __attribute__((ext_vector_type(4)));
typedef float f32x4 __attribute__((ext_vector_type(4)));
typedef float f32x2 __attribute__((ext_vector_type(2)));
typedef float f32x16 __attribute__((ext_vector_type(16)));
typedef unsigned u32x4 __attribute__((ext_vector_type(4)));
typedef unsigned u32x2 __attribute__((ext_vector_type(2)));
typedef __bf16 bf16x2_t __attribute__((ext_vector_type(2)));
#define MFMA32(a, b, c) __builtin_amdgcn_mfma_f32_32x32x16_bf16((a), (b), (c), 0, 0, 0)

constexpr int NTOK = 32768, DM = 1024, SEQ = 4096, NIN = 8264, NINP = 8448, NCD = 4352, PP = 4160, MISCP = 80;
constexpr float LOG2E = 1.4426950408889634f;
constexpr size_t WS_CTL = 0, WS_BIAS = 16384, WS_WIN = 1u << 20, WS_WOUT = WS_WIN + (size_t)2 * NINP * 1024 * 2, WS_HB = WS_WOUT + (size_t)4 * 1024 * 1024 * 2,
                 WS_PROJ = WS_HB + (size_t)NTOK * 1024 * 2, WS_MISC = WS_PROJ + (size_t)NTOK * PP * 2, WS_MIXED = WS_MISC + (size_t)NTOK * MISCP * 4,
                 WS_HSS = WS_MIXED + (size_t)NTOK * 1024 * 2, WS_Q = WS_HSS + (size_t)NTOK * 16 * 4, WS_BON = WS_Q + (size_t)NTOK * 512 * 2,
                 WS_HE = WS_BON + (size_t)NTOK * 8 * 4, WS_PE = WS_HE + (size_t)256 * 4096 * 4, WS_END = WS_PE + (size_t)256 * 4096 * 4;
constexpr int QSLOT_OFF = 143360, LDS_BYTES = QSLOT_OFF + 1024;

__device__ __forceinline__ unsigned pk2(float lo, float hi) { f32x2 v = {lo, hi}; bf16x2_t b = __builtin_convertvector(v, bf16x2_t); return __builtin_bit_cast(unsigned, b); }
typedef short v4i16_t __attribute__((ext_vector_type(4)));
__device__ __forceinline__ s16x4 vtr(const LAS unsigned char* p) { return __builtin_bit_cast(s16x4, __builtin_amdgcn_ds_read_tr16_b64_v4i16((LAS v4i16_t*)p)); }
__device__ __forceinline__ float bflo(unsigned u) { return __uint_as_float(u << 16); }
__device__ __forceinline__ float bfhi(unsigned u) { return __uint_as_float(u & 0xffff0000u); }
__device__ __forceinline__ float ex2(float x) { return __builtin_amdgcn_exp2f(x); }
__device__ __forceinline__ float lg2(float x) { return __builtin_amdgcn_logf(x); }
__device__ __forceinline__ float wave_sum(float v) {
#pragma unroll
    for (int o = 1; o < 64; o <<= 1) v += __shfl_xor(v, o);
    return v;
}
__device__ __forceinline__ float dpp_xor1(float v) { return __int_as_float(__builtin_amdgcn_update_dpp(0, __float_as_int(v), 0xB1, 0xF, 0xF, true)); }
__device__ __forceinline__ float dpp_xor2(float v) { return __int_as_float(__builtin_amdgcn_update_dpp(0, __float_as_int(v), 0x4E, 0xF, 0xF, true)); }
__device__ __forceinline__ float dpp_hmir(float v) { return __int_as_float(__builtin_amdgcn_update_dpp(0, __float_as_int(v), 0x141, 0xF, 0xF, true)); }
__device__ __forceinline__ float red8(float v) { v += dpp_xor1(v); v += dpp_xor2(v); v += dpp_hmir(v); return v; }
__device__ __forceinline__ float silu(float g) { return g * __builtin_amdgcn_rcpf(1.0f + __expf(-g)); }

struct Args {
    const float *x, *norm_gain, *w_in, *w_out, *rel_bias, *qk_gain, *diff_lambda, *forget_bias, *out_gain, *rwkv_mu, *rwkv_w_up, *rwkv_w0, *rwkv_a_up, *rwkv_a0, *rwkv_kkr, *rwkv_ln_gain, *rwkv_ln_bias;
    float* out; unsigned char* ws; int ph_lo, ph_hi;
};

__device__ __forceinline__ int refcol_in(int np) {
    if (np < 2048) return 4096 + np;
    if (np < 3584) return 6152 + (np - 2048);
    if (np < 4096) return 7752 + (np - 3584);
    if (np < 4160) return 7688 + (np - 4096);
    if (np < 4168) return 6144 + (np - 4160);
    if (np < 4352) return -1;
    return np - 4352;
}
template <bool MAPPED>
__device__ __forceinline__ void transpose_item(const float* W, int ldw, const float* gain, bf16_t* WT, LAS float* scr, int kb, int nb, int lane) {
    const int k0 = 64 * kb, n0 = 32 * nb;
    int rc = n0 + (lane & 31);
    if (MAPPED) rc = refcol_in(rc);
    float tv_[32];
#pragma unroll
    for (int i = 0; i < 32; ++i) {
        const int kk = 2 * i + (lane >> 5);
        float v = 0.f;
        if (rc >= 0) { v = W[(size_t)(k0 + kk) * ldw + rc]; if (MAPPED) v *= gain[k0 + kk]; }
        tv_[i] = v;
    }
#pragma unroll
    for (int i = 0; i < 32; ++i) scr[(2 * i + (lane >> 5)) * 33 + (lane & 31)] = tv_[i];
    asm volatile("s_waitcnt lgkmcnt(0)" ::: "memory");
    const int c = lane & 7;
#pragma unroll
    for (int j = 0; j < 4; ++j) {
        const int n = (lane >> 3) + 8 * j; const LAS float* s = scr + (8 * c) * 33 + n;
        u32x4 o; o.x = pk2(s[0 * 33], s[1 * 33]); o.y = pk2(s[2 * 33], s[3 * 33]); o.z = pk2(s[4 * 33], s[5 * 33]); o.w = pk2(s[6 * 33], s[7 * 33]);
        *(u32x4*)(WT + (size_t)(n0 + n) * 1024 + k0 + 8 * c) = o;
    }
    asm volatile("s_waitcnt lgkmcnt(0)" ::: "memory");
}

__device__ __forceinline__ void prologue(const Args& a, LAS unsigned char* lds) {
    const int tid = threadIdx.x, lane = tid & 63, wave = tid >> 6;
    LAS float* scr = (LAS float*)(lds + wave * 8704);
    const int gw = blockIdx.x * 8 + wave, NGW = gridDim.x * 8;
    bf16_t* WtIn = (bf16_t*)(a.ws + WS_WIN); bf16_t* WtOut = (bf16_t*)(a.ws + WS_WOUT);
    constexpr int I_IN = 16 * (NINP / 32), I_OUT = 16 * 32;
    constexpr int NITEMS = 2 * I_IN + 4 * I_OUT;
    for (int it = gw; it < NITEMS; it += NGW) {
        if (it < 2 * I_IN) {
            const int l = it / I_IN, r = it % I_IN, kb = r / (NINP / 32), nb = r % (NINP / 32);
            transpose_item<true>(a.w_in + (size_t)l * 1024 * NIN, NIN, a.norm_gain + l * 1024, WtIn + (size_t)l * NINP * 1024, scr, kb, nb, lane);
        } else {
            const int r0 = it - 2 * I_IN, mi = r0 / I_OUT, r = r0 % I_OUT, kb = r / 32, nb = r % 32, l = mi >> 1, half = mi & 1;
            transpose_item<false>(a.w_out + (size_t)l * 2048 * 1024 + (size_t)(half == 0 ? 1024 : 0) * 1024, 1024, nullptr, WtOut + (size_t)mi * 1024 * 1024, scr, kb, nb, lane);
        }
    }
    bf16_t* hb = (bf16_t*)(a.ws + WS_HB); float* hss = (float*)(a.ws + WS_HSS);
    for (int m0 = gw * 4; m0 < NTOK; m0 += NGW * 4) {
        f32x4 v[4][4];
#pragma unroll
        for (int r = 0; r < 4; ++r) { const f32x4* xr = (const f32x4*)(a.x + (size_t)(m0 + r) * 1024) + lane;
#pragma unroll
            for (int j = 0; j < 4; ++j) v[r][j] = xr[64 * j]; }
#pragma unroll
        for (int r = 0; r < 4; ++r) {
            float s = 0.f;
#pragma unroll
            for (int j = 0; j < 4; ++j) s += (v[r][j][0] * v[r][j][0] + v[r][j][1] * v[r][j][1]) + (v[r][j][2] * v[r][j][2] + v[r][j][3] * v[r][j][3]);
            s = wave_sum(s);
            u32x2* o8 = (u32x2*)(hb + (size_t)(m0 + r) * 1024) + lane;
#pragma unroll
            for (int j = 0; j < 4; ++j) { u32x2 w; w.x = pk2(v[r][j][0], v[r][j][1]); w.y = pk2(v[r][j][2], v[r][j][3]); o8[64 * j] = w; }
            if (lane < 16) hss[(size_t)(m0 + r) * 16 + lane] = (lane == 0) ? s : 0.f;
        }
    }
    if (blockIdx.x == 0) {
        float* bt = (float*)(a.ws + WS_BIAS);
        for (int e = tid; e < 1024; e += 512) {
            const int h = e >> 8, d = e & 255;
            int bk;
            if (d < 16) bk = d;
            else { const float lg = logf((float)d / 16.0f) / 2.0794415416798357f * 16.0f; bk = 16 + (int)lg; if (bk > 31) bk = 31; }
            bt[e] = a.rel_bias[bk * 4 + h] * LOG2E;
        }
    }
}

struct AttnP {
    const bf16_t* P; bf16_t* mixed; const float* misc;
    const float* qk_gain;
    const float* out_gain;
    const float* biasT;
    const float* fbias;
    float lam, oml;
};
__device__ __forceinline__ int crow(int r, int hi) { return (r & 3) + 8 * (r >> 2) + 4 * hi; }

template <int MODE>
__device__ __forceinline__ void attn_item(const AttnP& p, int b, int h, int qb, LAS unsigned char* lds) {
    constexpr int NC = (MODE == 0) ? 2 : 1, DK = 64 * NC, DV = 64 * NC, KP = DK + 8, VPT = DV + 32;
    constexpr int KS_BYTES = 64 * KP * 2, VT_BYTES = 64 * VPT * 2, BUF_BYTES = KS_BYTES + VT_BYTES + 256;
    constexpr int TAB_OFF = 2 * BUF_BYTES, FLAG_OFF = TAB_OFF + 1024, QP_OFF = FLAG_OFF + 512;
    constexpr bool QPARK = (MODE == 0);
    int tid_ = threadIdx.x; asm volatile("" : "+v"(tid_));
    const int tid = tid_, lane = tid & 63, w = __builtin_amdgcn_readfirstlane(tid >> 6), hh = lane >> 5, ln = lane & 31;
    const int qcol = ((MODE == 1) ? 2048 : 0) + h * DK, kcol = qcol + 512, vcol = qcol + 1024, gcol = qcol + 1536;
    const int mixcol = ((MODE == 1) ? 512 : 0) + h * DV;
    const int gaincol = ((MODE == 0) ? 0 : (MODE == 1) ? 512 : 1024) + h * DV;
    const int tok0 = b * SEQ, q0 = qb * 256, qw = q0 + 32 * w, qrow = qw + ln;
    const bf16_t* P = p.P;

    bf16x8 Qf[NC][4];
#pragma unroll
    for (int c = 0; c < NC; ++c) {
        u32x4 raw[4]; float ss = 0.f;
#pragma unroll
        for (int ks = 0; ks < 4; ++ks) {
            raw[ks] = *(const u32x4*)(P + (size_t)(tok0 + qrow) * PP + qcol + c * 64 + ks * 16 + hh * 8);
#pragma unroll
            for (int e = 0; e < 4; ++e) { const float lo = bflo(raw[ks][e]), hi = bfhi(raw[ks][e]); ss += lo * lo + hi * hi; }
        }
        float sc = 0.125f * LOG2E;
        if (MODE != 1) { ss += __shfl_xor(ss, 32); sc *= 1.0f / sqrtf(ss * (1.0f / 64.0f) + 1e-6f); }
#pragma unroll
        for (int ks = 0; ks < 4; ++ks) {
            u32x4 o;
#pragma unroll
            for (int e = 0; e < 4; ++e) {
                float lo = bflo(raw[ks][e]) * sc, hi = bfhi(raw[ks][e]) * sc;
                if (MODE != 1) {
                    const int d = ks * 16 + hh * 8 + 2 * e;
                    const float* gq = p.qk_gain + ((MODE == 0) ? 0 : 128); const float* gk = gq + 64;
                    lo *= gq[d] * gk[d]; hi *= gq[d + 1] * gk[d + 1];
                }
                o[e] = pk2(lo, hi);
            }
            Qf[c][ks] = __builtin_bit_cast(bf16x8, o);
            if (QPARK) *(LAS u32x4*)(lds + QP_OFF + w * 8192 + ((c * 4 + ks) * 64 + lane) * 16) = o;
        }
    }
    if (MODE == 0) { LAS float* tab = (LAS float*)(lds + TAB_OFF); if (tid < 256) tab[tid] = p.biasT[h * 256 + tid]; }
    LAS unsigned* flags = (LAS unsigned*)(lds + FLAG_OFF);
    if (MODE == 1 && tid < 16) flags[tid] = 0u;

    f32x16 O[NC][DV / 32];
#pragma unroll
    for (int c = 0; c < NC; ++c)
#pragma unroll
        for (int d = 0; d < DV / 32; ++d)
#pragma unroll
            for (int i = 0; i < 16; ++i) O[c][d][i] = 0.f;
    float mrun[NC], lsum[NC];
#pragma unroll
    for (int c = 0; c < NC; ++c) { mrun[c] = -1e30f; lsum[c] = 0.f; }
    float R2 = 0.f; bool mydone = false;
    float carry = 0.f, bq0 = 0.f, qk2 = 0.f;
    LAS unsigned* cflags = flags + 32;
    if (MODE == 2) {
        if (tid < 4) cflags[tid] = 0u;
        float gq_ = fabsf(p.qk_gain[128 + lane]), gk_ = fabsf(p.qk_gain[192 + lane]);
#pragma unroll
        for (int o_ = 1; o_ < 64; o_ <<= 1) { gq_ = fmaxf(gq_, __shfl_xor(gq_, o_)); gk_ = fmaxf(gk_, __shfl_xor(gk_, o_)); }
        qk2 = 8.0f * gq_ * gk_ * LOG2E * 1.02f;
    }
    const float fb = (MODE == 2) ? p.fbias[h] : 0.f;

    const int jt_max = qb * 4 + 3;
    u32x4 kreg[NC], vreg[NC]; float cfreg = 0.f;
#define ATT_LOADK(jt) do { _Pragma("unroll") for (int i_ = 0; i_ < NC; ++i_) { const int key_ = tid >> 3, dch_ = (tid & 7) + 8 * i_; \
            const bf16_t* rp_ = P + (size_t)(tok0 + (jt) * 64 + key_) * PP + dch_ * 8; kreg[i_] = *(const u32x4*)(rp_ + kcol); } \
        if (MODE == 2 && w == 0) cfreg = p.misc[(size_t)(tok0 + (jt) * 64 + lane) * MISCP + 64 + h]; } while (0)
#define ATT_LOADV(jt) do { _Pragma("unroll") for (int i_ = 0; i_ < NC; ++i_) { const int key_ = tid >> 3, dch_ = (tid & 7) + 8 * i_; \
            const bf16_t* rp_ = P + (size_t)(tok0 + (jt) * 64 + key_) * PP + dch_ * 8; vreg[i_] = *(const u32x4*)(rp_ + vcol); } } while (0)
#define ATT_LOAD(jt) do { ATT_LOADK(jt); ATT_LOADV(jt); } while (0)
#define ATT_STORE(buf, T_) do { LAS unsigned char* kb_ = lds + (buf) * BUF_BYTES; LAS unsigned char* vb_ = kb_ + KS_BYTES; \
        _Pragma("unroll") for (int i_ = 0; i_ < NC; ++i_) { const int key_ = tid >> 3, dch_ = (tid & 7) + 8 * i_; \
            u32x4 kv_ = kreg[i_]; \
            if (MODE != 1) { float ss_ = 0.f; _Pragma("unroll") for (int e_ = 0; e_ < 4; ++e_) { const float lo_ = bflo(kv_[e_]), hi_ = bfhi(kv_[e_]); ss_ += lo_ * lo_ + hi_ * hi_; } \
                ss_ = red8(ss_); const float inv_ = __builtin_amdgcn_rsqf(ss_ * (1.0f / 64.0f) + 1e-6f); \
                _Pragma("unroll") for (int e_ = 0; e_ < 4; ++e_) kv_[e_] = pk2(bflo(kv_[e_]) * inv_, bfhi(kv_[e_]) * inv_); } \
            *(LAS u32x4*)(kb_ + (key_ * KP + dch_ * 8) * 2) = kv_; \
            const u32x4 vv_ = vreg[i_]; \
            *(LAS u32x4*)(vb_ + (key_ * VPT + dch_ * 8) * 2) = vv_; } \
        if (MODE == 2 && w == 0) { const float x_ = cfreg + fb; const float lf_ = fminf(x_, 0.f) - __logf(1.0f + __expf(-fabsf(x_))); float s_ = lf_; \
            _Pragma("unroll") for (int o_ = 1; o_ < 64; o_ <<= 1) { const float t_ = __shfl_down(s_, o_); if (lane + o_ < 64) s_ += t_; } \
            const float bval_ = (carry + (s_ - lf_)) * LOG2E; ((LAS float*)(vb_ + VT_BYTES))[lane] = bval_; carry += __shfl(s_, 0); \
            if ((T_) == 4 * qb) bq0 = __shfl(bval_, 0); \
            const bool ex_ = ((T_) <= 4 * qb) && (12.0f + 2.0f * qk2 + carry * LOG2E - bq0 < -32.0f); \
            if (lane == 0) cflags[(T_) & 3] = ex_ ? 1u : 0u; } } while (0)

    ATT_LOAD(jt_max);
    ATT_STORE(0, jt_max);
    __syncthreads();
    float mfix = 0.f;
    if (MODE == 2) mfix = qk2;
    if (MODE == 0) {
        float gq_ = fabsf(p.qk_gain[lane]), gk_ = fabsf(p.qk_gain[64 + lane]);
        const LAS float* tab_ = (const LAS float*)(lds + TAB_OFF);
        float tm_ = fmaxf(fmaxf(fabsf(tab_[lane]), fabsf(tab_[64 + lane])), fmaxf(fabsf(tab_[128 + lane]), fabsf(tab_[192 + lane])));
#pragma unroll
        for (int o_ = 1; o_ < 64; o_ <<= 1) { gq_ = fmaxf(gq_, __shfl_xor(gq_, o_)); gk_ = fmaxf(gk_, __shfl_xor(gk_, o_)); tm_ = fmaxf(tm_, __shfl_xor(tm_, o_)); }
        mfix = 8.0f * gq_ * gk_ * LOG2E * 1.02f + tm_;
    }
    for (int it = 0; it <= jt_max; ++it) {
        const int jt = jt_max - it, k0 = jt * 64, buf = it & 1;
        const bool has_next = it < jt_max;
        if (has_next) { ATT_LOADK(jt - 1); ATT_LOADV(jt - 1); }
        LAS unsigned char* ksb = lds + buf * BUF_BYTES; LAS unsigned char* vtb = ksb + KS_BYTES;
#pragma unroll
        for (int kb2 = 1; kb2 >= 0; --kb2) {
            const int kp0 = k0 + 32 * kb2;
            bool active = (MODE == 1) ? (kp0 <= qw + 30) : (kp0 <= qw + 31);
            if (MODE == 1) active = active && !mydone;
            if (active) {
                f32x16 S[NC];
#define ATT_QK(c, INIT) do { _Pragma("unroll") for (int i = 0; i < 16; ++i) S[c][i] = (INIT); \
                    _Pragma("unroll") for (int ks = 0; ks < 4; ++ks) { const bf16x8 ka = *(const LAS bf16x8*)(ksb + ((32 * kb2 + ln) * KP + (c) * 64 + ks * 16 + hh * 8) * 2); const bf16x8 qf_ = (QPARK && (c) == 1) ? *(const LAS bf16x8*)(lds + QP_OFF + w * 8192 + (((c) * 4 + ks) * 64 + lane) * 16) : Qf[(QPARK && (c) == 1) ? 0 : (c)][ks]; S[c] = MFMA32(ka, qf_, S[c]); } } while (0)
                if (MODE == 1) ATT_QK(0, 0.f);
                const bool need_mask = (MODE == 1) ? (kp0 + 31 >= qw) : (kp0 + 31 > qw);
                bf16x8 pb[NC][2];
                if (MODE == 1) {
                    float L2[16], z2[16];
#pragma unroll
                    for (int i = 0; i < 16; ++i) {
                        z2[i] = S[0][i];
                        const bool valid = !need_mask || (kp0 + crow(i, hh) < qrow);
                        const float sp = fmaxf(z2[i], 0.f) + lg2(1.0f + ex2(-fabsf(z2[i])));
                        L2[i] = valid ? -sp : 0.f;
                    }
                    float G[4], PG[4], ag[4];
#pragma unroll
                    for (int g = 0; g < 4; ++g) { G[g] = (L2[4 * g] + L2[4 * g + 1]) + (L2[4 * g + 2] + L2[4 * g + 3]); PG[g] = __shfl_xor(G[g], 32); }
                    float accg = 0.f;
#pragma unroll
                    for (int g = 3; g >= 0; --g) { ag[g] = accg + (hh == 0 ? PG[g] : 0.f); accg += G[g] + PG[g]; }
                    float A[16];
#pragma unroll
                    for (int g = 0; g < 4; ++g) {
                        const float base = R2 + ag[g];
                        const float w3 = 0.f, w2 = L2[4 * g + 3], w1 = w2 + L2[4 * g + 2], w0 = w1 + L2[4 * g + 1];
                        const float wi[4] = {w0, w1, w2, w3};
#pragma unroll
                        for (int e = 0; e < 4; ++e) {
                            const int i = 4 * g + e;
                            const bool valid = !need_mask || (kp0 + crow(i, hh) < qrow);
                            A[i] = valid ? ex2(z2[i] + L2[i] + base + wi[e]) : 0.f;
                        }
                    }
                    R2 += accg;
#pragma unroll
                    for (int t2 = 0; t2 < 2; ++t2) {
                        u32x4 o; o.x = pk2(A[8 * t2], A[8 * t2 + 1]); o.y = pk2(A[8 * t2 + 2], A[8 * t2 + 3]); o.z = pk2(A[8 * t2 + 4], A[8 * t2 + 5]); o.w = pk2(A[8 * t2 + 6], A[8 * t2 + 7]);
                        pb[0][t2] = __builtin_bit_cast(bf16x8, o);
                    }
                } else {
#define ATT_TAIL(c) do { float ps = 0.f; float pe[16]; _Pragma("unroll") for (int i = 0; i < 16; ++i) { pe[i] = ex2(S[c][i]); ps += pe[i]; } lsum[c] += ps; \
                        _Pragma("unroll") for (int t2 = 0; t2 < 2; ++t2) { u32x4 o; o.x = pk2(pe[8 * t2], pe[8 * t2 + 1]); o.y = pk2(pe[8 * t2 + 2], pe[8 * t2 + 3]); o.z = pk2(pe[8 * t2 + 4], pe[8 * t2 + 5]); o.w = pk2(pe[8 * t2 + 6], pe[8 * t2 + 7]); \
                            pb[c][t2] = __builtin_bit_cast(bf16x8, o); } } while (0)
                    if (MODE == 0) {
                        const LAS float* tab = (const LAS float*)(lds + TAB_OFF);
                        if (qw - (kp0 + 31) >= 128) {
                            const float cb = tab[255] - mfix;
#pragma unroll
                            for (int c = 0; c < NC; ++c) { ATT_QK(c, cb); ATT_TAIL(c); }
                        } else {
                            float binit[16];
#pragma unroll
                            for (int i = 0; i < 16; ++i) {
                                const int dist = qrow - (kp0 + crow(i, hh));
                                binit[i] = (dist < 0) ? -3e38f : (tab[dist > 255 ? 255 : dist] - mfix);
                            }
#pragma unroll
                            for (int c = 0; c < NC; ++c) { ATT_QK(c, binit[i]); ATT_TAIL(c); }
                        }
                    } else {
                        float binit[16];
                        const LAS float* bl = (const LAS float*)(vtb + VT_BYTES) + 32 * kb2 + 4 * hh;
#pragma unroll
                        for (int g = 0; g < 4; ++g) {
                            const f32x4 t = *(const LAS f32x4*)(bl + 8 * g);
#pragma unroll
                            for (int e = 0; e < 4; ++e) binit[4 * g + e] = (need_mask && (kp0 + crow(4 * g + e, hh) > qrow)) ? -3e38f : (t[e] - mfix);
                        }
                        ATT_QK(0, binit[i]); ATT_TAIL(0);
                    }
#undef ATT_TAIL
                }
#pragma unroll
                for (int t2 = 0; t2 < 2; ++t2)
#pragma unroll
                    for (int d = 0; d < DV / 32; ++d) {
                        const LAS unsigned char* vp = vtb + ((32 * kb2 + 16 * t2 + 4 * hh + ((lane & 15) >> 2)) * VPT + d * 32 + 16 * ((lane >> 4) & 1) + 4 * (lane & 3)) * 2;
                        const s16x4 lo = vtr(vp), hi = vtr(vp + 8 * VPT * 2);
                        const bf16x8 va = __builtin_shufflevector(lo, hi, 0, 1, 2, 3, 4, 5, 6, 7);
#pragma unroll
                        for (int c = 0; c < NC; ++c) O[c][d] = MFMA32(va, pb[c][t2], O[c][d]);
                    }
            }
        }
        if (MODE == 1) {
            if (!mydone && __all(R2 < -45.0f)) mydone = true;
            if (lane == 0) flags[(it & 1) * 8 + w] = mydone ? 1u : 0u;
        }
        if (has_next) { ATT_STORE(buf ^ 1, jt - 1); }
        __syncthreads();
        if (MODE == 2) { if (cflags[jt & 3]) break; }
        if (MODE == 1) {
            unsigned alld = 1u;
#pragma unroll
            for (int i = 0; i < 8; ++i) alld &= flags[(it & 1) * 8 + i];
            if (alld) break;
        }
    }
#undef ATT_LOAD
#undef ATT_LOADK
#undef ATT_LOADV
#undef ATT_STORE
    float inv0 = 1.f, inv1 = 0.f;
    if (MODE != 1) { float l0 = lsum[0]; l0 += __shfl_xor(l0, 32); inv0 = 1.0f / l0; }
    if (MODE == 0) { float l1 = lsum[NC - 1]; l1 += __shfl_xor(l1, 32); inv1 = p.lam / l1; }
    float ss = 0.f;
#pragma unroll
    for (int d = 0; d < DV / 32; ++d)
#pragma unroll
        for (int i = 0; i < 16; ++i) {
            float o = O[0][d][i] * inv0;
            if (MODE == 0) o -= O[NC - 1][d][i] * inv1;
            O[0][d][i] = o; ss += o * o;
        }
    ss += __shfl_xor(ss, 32);
    float rn = 1.0f / sqrtf(ss * (1.0f / DV) + 1e-6f);
    if (MODE == 0) rn *= p.oml;
    int qrow_e = qrow; asm volatile("" : "+v"(qrow_e));
    const size_t trow = (size_t)(tok0 + qrow_e);
#pragma unroll
    for (int d = 0; d < DV / 32; ++d)
#pragma unroll
        for (int g = 0; g < 4; ++g) {
            const int dd = d * 32 + 8 * g + 4 * hh;
            const u32x2 gr = *(const u32x2*)(P + trow * PP + gcol + dd);
            const f32x4 og = *(const f32x4*)(p.out_gain + gaincol + dd);
            const float o0 = O[0][d][4 * g] * rn * og[0] * silu(bflo(gr.x)), o1 = O[0][d][4 * g + 1] * rn * og[1] * silu(bfhi(gr.x));
            const float o2 = O[0][d][4 * g + 2] * rn * og[2] * silu(bflo(gr.y)), o3 = O[0][d][4 * g + 3] * rn * og[3] * silu(bfhi(gr.y));
            u32x2 wv; wv.x = pk2(o0, o1); wv.y = pk2(o2, o3);
            *(u32x2*)(p.mixed + trow * 1024 + mixcol + dd) = wv;
        }
}

struct ScanP {
    const bf16_t* P; bf16_t* mixed; const float* misc;
    const float *mu, *w_up, *w0, *a_up, *a0, *kkr, *ln_gain, *ln_bias, *out_gain;
    bf16_t* Q; float* bon; float* HE; float* PE;
};
__device__ __forceinline__ float red16(float v) { v = red8(v); v += __int_as_float(__builtin_amdgcn_update_dpp(0, __float_as_int(v), 0x140, 0xF, 0xF, true)); return v; }

__device__ __forceinline__ bf16x8 pack8(const f32x16& x, int s) {
    u32x4 o; o.x = pk2(x[8 * s], x[8 * s + 1]); o.y = pk2(x[8 * s + 2], x[8 * s + 3]); o.z = pk2(x[8 * s + 4], x[8 * s + 5]); o.w = pk2(x[8 * s + 6], x[8 * s + 7]);
    return __builtin_bit_cast(bf16x8, o);
}
__device__ __forceinline__ bf16x8 ld_krow(const LAS unsigned char* p) {
    const s16x4 lo = *(const LAS s16x4*)p, hi = *(const LAS s16x4*)(p + 16);
    return __builtin_shufflevector(lo, hi, 0, 1, 2, 3, 4, 5, 6, 7);
}
__device__ __forceinline__ void scan_pass1(const ScanP& sp, int b, int h, int seg, LAS unsigned char* lds) {
    int tid_ = threadIdx.x; asm volatile("" : "+v"(tid_));
    const int tid = tid_, lane = tid & 63, w = __builtin_amdgcn_readfirstlane(tid >> 6);
    constexpr int O_WUP = 0, O_AUP = 8192, O_LORA = 16384, O_LW = 24576, O_KK = 32768, O_R = 37376, O_K = 41984, O_B = 46592, O_KT = 51200, O_BT = 56320, O_VT = 61440,
                  O_MK = 66560, O_NK = 69120, O_TM = 71680, O_NB = 74240, O_NT = 76800, O_GAM = 80896, O_VV = 81152, O_SC = 89344, O_YB = 89856, O_N21 = 109056;
    LAS float* wup = (LAS float*)(lds + O_WUP); LAS float* aup = (LAS float*)(lds + O_AUP); LAS float* lora = (LAS float*)(lds + O_LORA); LAS float* lwS = (LAS float*)(lds + O_LW);
    LAS float* NT = (LAS float*)(lds + O_NT); LAS float* gam = (LAS float*)(lds + O_GAM); LAS float* vvv = (LAS float*)(lds + O_VV); LAS float* scl = (LAS float*)(lds + O_SC); LAS float* yb = (LAS float*)(lds + O_YB); LAS float* qb = (LAS float*)(lds + 100864);
    LAS float* stash = (LAS float*)(lds + 117248);
    const int tok0 = b * SEQ;
    const int tt = tid >> 4, jg = tid & 15, j4 = 4 * jg, ch = h * 64 + j4;
    __syncthreads();
    for (int e = tid; e < 2048; e += 512) { const int m = e >> 6, j = e & 63;
        ((LAS unsigned short*)(lds + O_WUP))[j * 40 + m] = (unsigned short)(pk2(sp.w_up[m * 512 + h * 64 + j], 0.f) & 0xffffu);
        ((LAS unsigned short*)(lds + O_WUP + 5120))[j * 40 + m] = (unsigned short)(pk2(sp.a_up[m * 512 + h * 64 + j], 0.f) & 0xffffu); }
    LAS float* par = (LAS float*)(lds + 98048);
    if (tid < 64) {
        const int c_ = h * 64 + tid;
        par[0 * 64 + tid] = sp.mu[c_]; par[1 * 64 + tid] = sp.mu[512 + c_]; par[2 * 64 + tid] = sp.mu[1024 + c_]; par[3 * 64 + tid] = sp.mu[1536 + tid];
        par[4 * 64 + tid] = sp.w0[c_]; par[5 * 64 + tid] = sp.a0[c_]; par[6 * 64 + tid] = sp.kkr[c_]; par[7 * 64 + tid] = sp.kkr[512 + c_]; par[8 * 64 + tid] = sp.kkr[1024 + c_];
        par[9 * 64 + tid] = sp.ln_gain[c_] * sp.out_gain[1536 + c_]; par[10 * 64 + tid] = sp.ln_bias[c_];
    }
#define PARV(k) (*(const LAS f32x4*)(par + (k) * 64 + j4))
    __syncthreads();
    f32x16 Hacc[2];
    {
        const int ln0 = lane & 31, hh0 = lane >> 5, cb0 = w & 1;
#pragma unroll
        for (int jb = 0; jb < 2; ++jb)
#pragma unroll
            for (int i = 0; i < 16; ++i) Hacc[jb][i] = (w >= 2 && w < 4 && (32 * jb + crow(i, hh0)) == (32 * cb0 + ln0)) ? 1.f : 0.f;
    }
    f32x4 n_cur, n_prv; u32x2 n_rc, n_kc, n_vc, n_rq, n_kq, n_vq;
#define SCAN_PREFETCH(tk, hasprev) do { const size_t tk_ = (tk); n_cur = *(const f32x4*)(sp.misc + tk_ * MISCP + j4); const bf16_t* rp_ = sp.P + tk_ * PP + 2048 + ch; \
        n_rc = *(const u32x2*)rp_; n_kc = *(const u32x2*)(rp_ + 512); n_vc = *(const u32x2*)(rp_ + 1024); \
        if (hasprev) { n_prv = *(const f32x4*)(sp.misc + (tk_ - 1) * MISCP + j4); n_rq = *(const u32x2*)(rp_ - PP); n_kq = *(const u32x2*)(rp_ - PP + 512); n_vq = *(const u32x2*)(rp_ - PP + 1024); } \
        else { n_prv = (f32x4){0.f, 0.f, 0.f, 0.f}; n_rq = (u32x2){0u, 0u}; n_kq = n_rq; n_vq = n_rq; } } while (0)
    SCAN_PREFETCH((size_t)(tok0 + seg * 1024 + tt), (seg * 1024 + tt) > 0);
    f32x4 r4, k4, v4, lw, kkn, kp, bb; float bon = 0.f;
    for (int ci = -1; ci < 32; ++ci) {
        f32x16 P1, P2;
        int lnv_ = lane; asm volatile("" : "+v"(lnv_)); const int ln = lnv_ & 31, hh = lnv_ >> 5;
        const float bon_c = bon; const int tokc_i = tok0 + seg * 1024 + ci * 32 + tt;
        if (ci >= 0) {
        __syncthreads();
        {
            const f32x4 r4 = *(const LAS f32x4*)(stash + tid * 12), v4 = *(const LAS f32x4*)(stash + tid * 12 + 4), kp = *(const LAS f32x4*)(stash + tid * 12 + 8);
            f32x4 cl = {0.f, 0.f, 0.f, 0.f};
#pragma unroll 2
            for (int s4 = 0; s4 < w; ++s4) {
                const LAS float* lp_ = lwS + (4 * s4) * 64 + j4;
                const f32x4 x0 = *(const LAS f32x4*)lp_, x1 = *(const LAS f32x4*)(lp_ + 64), x2 = *(const LAS f32x4*)(lp_ + 128), x3 = *(const LAS f32x4*)(lp_ + 192);
                cl += (x0 + x1) + (x2 + x3);
            }
#pragma unroll
            for (int q = 0; q < 4; ++q) { const int s = 4 * w + q; const f32x4 x = *(const LAS f32x4*)(lwS + s * 64 + j4); if (s <= tt) cl += x; }
            f32x4 ein, eex, einv;
#pragma unroll
            for (int e = 0; e < 4; ++e) { ein[e] = __expf(cl[e]); eex[e] = __expf(cl[e] - lw[e]); einv[e] = __expf(-cl[e]); }
            const f32x4 kkt = kkn * eex, rt = r4 * ein, kh = kp * einv, bh = bb * einv;
            u32x2 o;
            o.x = pk2(kkt[0], kkt[1]); o.y = pk2(kkt[2], kkt[3]); *(LAS u32x2*)(lds + O_KK + (tt * 72 + j4) * 2) = o;
            o.x = pk2(rt[0], rt[1]); o.y = pk2(rt[2], rt[3]); *(LAS u32x2*)(lds + O_R + (tt * 72 + j4) * 2) = o;
            o.x = pk2(kh[0], kh[1]); o.y = pk2(kh[2], kh[3]); *(LAS u32x2*)(lds + O_K + (tt * 72 + j4) * 2) = o;
            const unsigned k01 = o.x, k23 = o.y;
            o.x = pk2(bh[0], bh[1]); o.y = pk2(bh[2], bh[3]); *(LAS u32x2*)(lds + O_B + (tt * 72 + j4) * 2) = o;
            const unsigned nb01 = pk2(-bh[0], -bh[1]), nb23 = pk2(-bh[2], -bh[3]);
            const unsigned v01 = pk2(v4[0], v4[1]), v23 = pk2(v4[2], v4[3]);
            LAS unsigned short* kt = (LAS unsigned short*)(lds + O_KT) + j4 * 40 + tt;
            kt[0] = (unsigned short)(k01 & 0xffffu); kt[40] = (unsigned short)(k01 >> 16); kt[80] = (unsigned short)(k23 & 0xffffu); kt[120] = (unsigned short)(k23 >> 16);
            LAS unsigned short* bt = (LAS unsigned short*)(lds + O_BT) + j4 * 40 + tt;
            bt[0] = (unsigned short)(nb01 & 0xffffu); bt[40] = (unsigned short)(nb01 >> 16); bt[80] = (unsigned short)(nb23 & 0xffffu); bt[120] = (unsigned short)(nb23 >> 16);
            LAS unsigned short* vt = (LAS unsigned short*)(lds + O_VT) + j4 * 40 + tt;
            vt[0] = (unsigned short)(v01 & 0xffffu); vt[40] = (unsigned short)(v01 >> 16); vt[80] = (unsigned short)(v23 & 0xffffu); vt[120] = (unsigned short)(v23 >> 16);
            if (tt == 31) *(LAS f32x4*)(gam + j4) = ein;
        }
        __syncthreads();
        if (w < 4) {
#pragma unroll
            for (int i = 0; i < 16; ++i) { P1[i] = 0.f; P2[i] = 0.f; }
#pragma unroll
            for (int jb = 0; jb < 2; ++jb)
#pragma unroll
                for (int s = 0; s < 2; ++s) {
                    const bf16x8 hb = pack8(Hacc[jb], s);
                    const int off = (ln * 72 + 32 * jb + 16 * s + 4 * hh) * 2;
                    P1 = MFMA32(ld_krow(lds + O_KK + off), hb, P1);
                    P2 = MFMA32(ld_krow(lds + O_R + off), hb, P2);
                }
        } else {
            const int job = w - 4;
            const int oa = (job == 0 || job == 2) ? O_K : O_B, ob = (job < 2) ? O_KK : O_R;
            f32x16 Z;
#pragma unroll
            for (int i = 0; i < 16; ++i) Z[i] = 0.f;
#pragma unroll
            for (int ks = 0; ks < 4; ++ks) {
                const int off = (ln * 72 + ks * 16 + hh * 8) * 2;
                Z = MFMA32(*(const LAS bf16x8*)(lds + oa + off), *(const LAS bf16x8*)(lds + ob + off), Z);
            }
            if (job == 1) {
#pragma unroll
                for (int r = 0; r < 16; ++r) { const int c = crow(r, hh); NT[c * 32 + ln] = (c < ln) ? Z[r] : 0.f; }
                {
                    const bool lowrow = ln < 16;
                    u32x2 a_, b_;
                    a_.x = lowrow ? 0u : pk2(-Z[0], -Z[1]); a_.y = lowrow ? 0u : pk2(-Z[2], -Z[3]);
                    b_.x = lowrow ? 0u : pk2(-Z[4], -Z[5]); b_.y = lowrow ? 0u : pk2(-Z[6], -Z[7]);
                    *(LAS u32x2*)(lds + O_N21 + (ln * 40 + 4 * hh) * 2) = a_;
                    *(LAS u32x2*)(lds + O_N21 + (ln * 40 + 8 + 4 * hh) * 2) = b_;
                }
                asm volatile("s_waitcnt lgkmcnt(0)" ::: "memory");
                float Tr[16];
                const int tb = ln >> 4, tl = ln & 15;
                const LAS float* NTl = NT + tb * (16 * 32 + 16); asm volatile("" : "+v"(NTl));
                f32x4 nvc[4], nvn[4];
#pragma unroll
                for (int m = 0; m < 4; ++m) { nvc[m] = (f32x4){0.f, 0.f, 0.f, 0.f}; nvn[m] = nvc[m]; }
#pragma unroll
                for (int cc = 0; cc < 16; ++cc) {
                    const int cl = 15 - cc;
                    if (cl >= 1) {
#pragma unroll
                        for (int m = 0; m < 4; ++m) if (4 * m + 3 > cl - 1) nvn[m] = *(const LAS f32x4*)(NTl + (cl - 1) * 32 + 4 * m);
                    }
                    float s0 = (cl == tl) ? 1.f : 0.f, s1 = 0.f, s2 = 0.f, s3 = 0.f;
#pragma unroll
                    for (int m = 0; m < 4; ++m) {
                        if (4 * m + 3 > cl) {
                            if (4 * m + 0 > cl) s0 -= Tr[4 * m + 0] * nvc[m][0];
                            if (4 * m + 1 > cl) s1 -= Tr[4 * m + 1] * nvc[m][1];
                            if (4 * m + 2 > cl) s2 -= Tr[4 * m + 2] * nvc[m][2];
                            if (4 * m + 3 > cl) s3 -= Tr[4 * m + 3] * nvc[m][3];
                        }
                    }
                    Tr[cl] = (s0 + s1) + (s2 + s3);
                    asm volatile("" : "+v"(Tr[cl]) :: "memory");
#pragma unroll
                    for (int m = 0; m < 4; ++m) nvc[m] = nvn[m];
                }
                if (hh == 0) {
#pragma unroll
                    for (int q = 0; q < 4; ++q) {
                        const bool mine = (q >> 1) == tb; const int o8 = 8 * (q & 1);
                        u32x4 o; o.x = mine ? pk2(Tr[o8], Tr[o8 + 1]) : 0u; o.y = mine ? pk2(Tr[o8 + 2], Tr[o8 + 3]) : 0u; o.z = mine ? pk2(Tr[o8 + 4], Tr[o8 + 5]) : 0u; o.w = mine ? pk2(Tr[o8 + 6], Tr[o8 + 7]) : 0u;
                        *(LAS u32x4*)(lds + O_TM + ln * 80 + 16 * q) = o;
                    }
                }
            } else {
                const int oo = (job == 0) ? O_MK : (job == 2) ? O_NK : O_NB;
#pragma unroll
                for (int g = 0; g < 4; ++g) {
                    float z[4];
#pragma unroll
                    for (int e = 0; e < 4; ++e) {
                        const int s = 8 * g + 4 * hh + e;
                        const bool keep = (job == 0) ? (s < ln) : (s <= ln);
                        float v = keep ? Z[4 * g + e] : 0.f; if (job == 3) v = -v; z[e] = v;
                    }
                    u32x2 o; o.x = pk2(z[0], z[1]); o.y = pk2(z[2], z[3]);
                    *(LAS u32x2*)(lds + oo + (ln * 40 + 8 * g + 4 * hh) * 2) = o;
                }
            }
        }
        }
        if (ci + 1 < 32) {
        const int chunk = ci + 1;
        const int t0 = seg * 1024 + chunk * 32, t = t0 + tt; const size_t tok = (size_t)(tok0 + t);
        {
            const f32x4 cur = n_cur, prv = n_prv;
            f32x4 s = cur + (prv - cur) * PARV(3);
            if (jg < 8) {
#pragma unroll
                for (int e = 0; e < 4; ++e) s[e] = 1.0f - 2.0f * __builtin_amdgcn_rcpf(1.0f + __expf(2.0f * s[e]));
            }
            { u32x2 o_; o_.x = pk2(s[0], s[1]); o_.y = pk2(s[2], s[3]); *(LAS u32x2*)(lds + O_LORA + (tt * 72 + j4) * 2) = o_; }
        }
        {
            const u32x2 rc = n_rc, kc = n_kc, vc = n_vc, rq = n_rq, kq = n_kq, vq = n_vq;
            const f32x4 rcf = {bflo(rc.x), bfhi(rc.x), bflo(rc.y), bfhi(rc.y)}, rqf = {bflo(rq.x), bfhi(rq.x), bflo(rq.y), bfhi(rq.y)};
            const f32x4 kcf = {bflo(kc.x), bfhi(kc.x), bflo(kc.y), bfhi(kc.y)}, kqf = {bflo(kq.x), bfhi(kq.x), bflo(kq.y), bfhi(kq.y)};
            const f32x4 vcf = {bflo(vc.x), bfhi(vc.x), bflo(vc.y), bfhi(vc.y)}, vqf = {bflo(vq.x), bfhi(vq.x), bflo(vq.y), bfhi(vq.y)};
            r4 = rcf + (rqf - rcf) * PARV(0); k4 = kcf + (kqf - kcf) * PARV(1); v4 = vcf + (vqf - vcf) * PARV(2);
        }
        if (chunk + 1 < 32) SCAN_PREFETCH(tok + 32, 1);
        asm volatile("s_waitcnt lgkmcnt(0)" ::: "memory");
        bon = 0.f;
        {
            f32x4 wacc, aacc;
            {
                const int l5_ = lane & 31, h5_ = lane >> 5;
                const LAS unsigned char* arow = lds + O_LORA + ((4 * w + (l5_ & 3)) * 72 + h5_ * 8) * 2;
#pragma unroll
                for (int lo_ = 0; lo_ < 2; ++lo_)
#pragma unroll
                    for (int jb_ = 0; jb_ < 2; ++jb_) {
                        f32x16 D_;
#pragma unroll
                        for (int i = 0; i < 16; ++i) D_[i] = 0.f;
#pragma unroll
                        for (int ks = 0; ks < 2; ++ks)
                            D_ = MFMA32(*(const LAS bf16x8*)(arow + (lo_ * 32 + ks * 16) * 2), *(const LAS bf16x8*)(lds + O_WUP + lo_ * 5120 + ((32 * jb_ + l5_) * 40 + ks * 16 + h5_ * 8) * 2), D_);
                        if (h5_ == 0) {
                            LAS float* dst_ = (lo_ == 0 ? yb : qb) + (w * 4) * 64 + 32 * jb_ + l5_;
                            dst_[0] = D_[0]; dst_[64] = D_[1]; dst_[128] = D_[2]; dst_[192] = D_[3];
                        }
                    }
                asm volatile("s_waitcnt lgkmcnt(0)" ::: "memory");
                wacc = PARV(4) + *(const LAS f32x4*)(yb + (w * 4 + (lane >> 4)) * 64 + j4);
                aacc = PARV(5) + *(const LAS f32x4*)(qb + (w * 4 + (lane >> 4)) * 64 + j4);
            }
            float ssq = 0.f; f32x4 av;
#pragma unroll
            for (int e = 0; e < 4; ++e) {
                const float xw = -wacc[e]; const float spv = fmaxf(xw, 0.f) + __logf(1.0f + __expf(-fabsf(xw)));
                lw[e] = -__expf(-spv - 0.5f);
                av[e] = __builtin_amdgcn_rcpf(1.0f + __expf(-aacc[e]));
                kkn[e] = k4[e] * PARV(6)[e]; ssq += kkn[e] * kkn[e];
            }
            ssq = red16(ssq);
            const float inrm = __builtin_amdgcn_rsqf(fmaxf(ssq, 1e-24f));
#pragma unroll
            for (int e = 0; e < 4; ++e) {
                kkn[e] *= inrm; kp[e] = k4[e] * (1.0f + (av[e] - 1.0f) * PARV(7)[e]); bb[e] = kkn[e] * av[e];
                bon += r4[e] * kp[e] * PARV(8)[e];
            }
            bon = red16(bon);
            *(LAS f32x4*)(lwS + tt * 64 + j4) = lw;
            *(LAS f32x4*)(stash + tid * 12) = r4; *(LAS f32x4*)(stash + tid * 12 + 4) = v4; *(LAS f32x4*)(stash + tid * 12 + 8) = kp;
        }
        }
        if (ci >= 0) {
        __syncthreads();
        if (w < 4) {
            const bool isH = w < 2;
            const int icol = 32 * (w & 1) + ln;
            bf16x8 vfr[2];
            if (isH) {
#pragma unroll
                for (int ks = 0; ks < 2; ++ks) vfr[ks] = *(const LAS bf16x8*)(lds + O_VT + (icol * 40 + ks * 16 + hh * 8) * 2);
#pragma unroll
                for (int ks = 0; ks < 2; ++ks) {
                    P1 = MFMA32(*(const LAS bf16x8*)(lds + O_MK + (ln * 40 + ks * 16 + hh * 8) * 2), vfr[ks], P1);
                    P2 = MFMA32(*(const LAS bf16x8*)(lds + O_NK + (ln * 40 + ks * 16 + hh * 8) * 2), vfr[ks], P2);
                }
            }
            f32x16 Aa;
#pragma unroll
            for (int i = 0; i < 16; ++i) Aa[i] = 0.f;
#pragma unroll
            for (int s = 0; s < 1; ++s) Aa = MFMA32(ld_krow(lds + O_TM + (ln * 40 + 4 * hh) * 2), pack8(P1, 0), Aa);
            P1 = MFMA32(ld_krow(lds + O_N21 + (ln * 40 + 4 * hh) * 2), pack8(Aa, 0), P1);
            Aa = MFMA32(ld_krow(lds + O_TM + (ln * 40 + 16 + 4 * hh) * 2), pack8(P1, 1), Aa);
            bf16x8 ab[2]; ab[0] = pack8(Aa, 0); ab[1] = pack8(Aa, 1);
#pragma unroll
            for (int s = 0; s < 2; ++s) P2 = MFMA32(ld_krow(lds + O_NB + (ln * 40 + 16 * s + 4 * hh) * 2), ab[s], P2);
#pragma unroll
            for (int jb = 0; jb < 2; ++jb) {
                if (isH) {
#pragma unroll
                    for (int ks = 0; ks < 2; ++ks) Hacc[jb] = MFMA32(*(const LAS bf16x8*)(lds + O_KT + ((32 * jb + ln) * 40 + ks * 16 + hh * 8) * 2), vfr[ks], Hacc[jb]);
                }
#pragma unroll
                for (int s = 0; s < 2; ++s) Hacc[jb] = MFMA32(ld_krow(lds + O_BT + ((32 * jb + ln) * 40 + 16 * s + 4 * hh) * 2), ab[s], Hacc[jb]);
#pragma unroll
                for (int g = 0; g < 4; ++g) {
                    const f32x4 gv = *(const LAS f32x4*)(gam + 32 * jb + 8 * g + 4 * hh);
                    Hacc[jb][4 * g] *= gv[0]; Hacc[jb][4 * g + 1] *= gv[1]; Hacc[jb][4 * g + 2] *= gv[2]; Hacc[jb][4 * g + 3] *= gv[3];
                }
            }
            LAS float* ob = isH ? yb : qb;
#pragma unroll
            for (int r = 0; r < 16; ++r) ob[crow(r, hh) * 64 + icol] = P2[r];
        }
        __syncthreads();
        {
            const f32x4 y = *(const LAS f32x4*)(yb + tt * 64 + j4);
            const f32x4 q = *(const LAS f32x4*)(qb + tt * 64 + j4);
            u32x2 o; o.x = pk2(y[0], y[1]); o.y = pk2(y[2], y[3]);
            *(u32x2*)(sp.mixed + (size_t)tokc_i * 1024 + 512 + ch) = o;
            o.x = pk2(q[0], q[1]); o.y = pk2(q[2], q[3]);
            *(u32x2*)(sp.Q + (size_t)tokc_i * 512 + ch) = o;
            if (jg == 0) sp.bon[(size_t)tokc_i * 8 + h] = bon_c;
        }
        }
    }
    if (w < 4) {
        int le_ = lane; asm volatile("" : "+v"(le_));
        const int ln = le_ & 31, hh = le_ >> 5, icol = 32 * (w & 1) + ln;
        float* dst = ((w < 2) ? sp.HE : sp.PE) + (size_t)((b * 8 + h) * 4 + seg) * 4096;
#pragma unroll
        for (int jb = 0; jb < 2; ++jb)
#pragma unroll
            for (int r = 0; r < 16; ++r) dst[(32 * jb + crow(r, hh)) * 64 + icol] = Hacc[jb][r];
    }
#undef SCAN_PREFETCH
#undef PARV
}

__device__ __forceinline__ void scan_pass2(const ScanP& sp, int b, int h, int seg, LAS unsigned char* lds) {
    int tid_ = threadIdx.x; asm volatile("" : "+v"(tid_));
    const int tid = tid_, lane = tid & 63, w = __builtin_amdgcn_readfirstlane(tid >> 6);
    LAS float* Hc = (LAS float*)lds; LAS float* Hn = Hc + 4096;
    LAS unsigned char* HiT = lds + 32768;
    LAS float* par = (LAS float*)(lds + 32768 + 9216);
    LAS float* ybw = (LAS float*)(lds + 43008) + w * 2048;
    const int tok0 = b * SEQ;
    __syncthreads();
    if (tid < 64) { const int c_ = h * 64 + tid; par[tid] = sp.mu[1024 + c_]; par[64 + tid] = sp.ln_gain[c_] * sp.out_gain[1536 + c_]; par[128 + tid] = sp.ln_bias[c_]; }
    const int j = tid >> 3, i8 = (tid & 7) * 8;
    *(LAS f32x4*)(Hc + j * 64 + i8) = (f32x4){0.f, 0.f, 0.f, 0.f}; *(LAS f32x4*)(Hc + j * 64 + i8 + 4) = (f32x4){0.f, 0.f, 0.f, 0.f};
    __syncthreads();
    for (int s = 0; s < seg; ++s) {
        const float* HE = sp.HE + (size_t)((b * 8 + h) * 4 + s) * 4096; const float* PE = sp.PE + (size_t)((b * 8 + h) * 4 + s) * 4096;
        f32x4 a0 = *(const f32x4*)(HE + j * 64 + i8), a1 = *(const f32x4*)(HE + j * 64 + i8 + 4);
        f32x4 pvr[16];
#pragma unroll
        for (int jq = 0; jq < 16; ++jq) pvr[jq] = *(const f32x4*)(PE + j * 64 + 4 * jq);
#pragma unroll
        for (int jq = 0; jq < 16; ++jq) {
#pragma unroll
            for (int q = 0; q < 4; ++q) {
                const f32x4 h0 = *(const LAS f32x4*)(Hc + (4 * jq + q) * 64 + i8), h1 = *(const LAS f32x4*)(Hc + (4 * jq + q) * 64 + i8 + 4);
                a0 += h0 * pvr[jq][q]; a1 += h1 * pvr[jq][q];
            }
        }
        *(LAS f32x4*)(Hn + j * 64 + i8) = a0; *(LAS f32x4*)(Hn + j * 64 + i8 + 4) = a1;
        __syncthreads();
        LAS float* t_ = Hc; Hc = Hn; Hn = t_;
    }
    {
        const f32x4 h0 = *(const LAS f32x4*)(Hc + j * 64 + i8), h1 = *(const LAS f32x4*)(Hc + j * 64 + i8 + 4);
        const unsigned p0 = pk2(h0[0], h0[1]), p1 = pk2(h0[2], h0[3]), p2 = pk2(h1[0], h1[1]), p3 = pk2(h1[2], h1[3]);
        LAS unsigned short* d = (LAS unsigned short*)HiT + i8 * 72 + j;
        d[0] = (unsigned short)(p0 & 0xffffu); d[72] = (unsigned short)(p0 >> 16); d[144] = (unsigned short)(p1 & 0xffffu); d[216] = (unsigned short)(p1 >> 16);
        d[288] = (unsigned short)(p2 & 0xffffu); d[360] = (unsigned short)(p2 >> 16); d[432] = (unsigned short)(p3 & 0xffffu); d[504] = (unsigned short)(p3 >> 16);
    }
    __syncthreads();
    const int ln = lane & 31, hh = lane >> 5;
    for (int c = w; c < 32; c += 8) {
        const int t0 = seg * 1024 + c * 32;
#pragma unroll
        for (int ib = 0; ib < 2; ++ib) {
            f32x16 acc;
#pragma unroll
            for (int i = 0; i < 16; ++i) acc[i] = 0.f;
#pragma unroll
            for (int ks = 0; ks < 4; ++ks) {
                const bf16x8 qa = *(const bf16x8*)(sp.Q + (size_t)(tok0 + t0 + ln) * 512 + h * 64 + ks * 16 + hh * 8);
                const bf16x8 hb = *(const LAS bf16x8*)(HiT + ((ib * 32 + ln) * 72 + ks * 16 + hh * 8) * 2);
                acc = MFMA32(qa, hb, acc);
            }
#pragma unroll
            for (int r = 0; r < 16; ++r) ybw[crow(r, hh) * 64 + ib * 32 + ln] = acc[r];
        }
        asm volatile("s_waitcnt lgkmcnt(0)" ::: "memory");
#pragma unroll 4
        for (int it = 0; it < 8; ++it) {
            const int item = it * 64 + lane, tt = item >> 4, jg = item & 15, j4 = 4 * jg, ch = h * 64 + j4;
            const int t = t0 + tt; const size_t tok = (size_t)(tok0 + t);
            const u32x2 y0 = *(const u32x2*)(sp.mixed + tok * 1024 + 512 + ch);
            const f32x4 dy = *(const LAS f32x4*)(ybw + tt * 64 + j4);
            const f32x4 y = {bflo(y0.x) + dy[0], bfhi(y0.x) + dy[1], bflo(y0.y) + dy[2], bfhi(y0.y) + dy[3]};
            const float mean = red16((y[0] + y[1]) + (y[2] + y[3])) * (1.0f / 64.0f);
            const f32x4 dlt = y - mean;
            const float var = red16((dlt[0] * dlt[0] + dlt[1] * dlt[1]) + (dlt[2] * dlt[2] + dlt[3] * dlt[3])) * (1.0f / 64.0f);
            const float rs = __builtin_amdgcn_rsqf(var + 64e-5f);
            const bf16_t* vp = sp.P + tok * PP + 3072 + ch;
            const u32x2 vc = *(const u32x2*)vp; u32x2 vq = {0u, 0u}; if (t > 0) vq = *(const u32x2*)(vp - PP);
            const f32x4 vcf = {bflo(vc.x), bfhi(vc.x), bflo(vc.y), bfhi(vc.y)}, vqf = {bflo(vq.x), bfhi(vq.x), bflo(vq.y), bfhi(vq.y)};
            const f32x4 v4 = vcf + (vqf - vcf) * *(const LAS f32x4*)(par + j4);
            const float bon = sp.bon[tok * 8 + h];
            const u32x2 gr = *(const u32x2*)(sp.P + tok * PP + 3584 + ch);
            const f32x4 yo = dlt * rs * *(const LAS f32x4*)(par + 64 + j4) + *(const LAS f32x4*)(par + 128 + j4) + v4 * bon;
            u32x2 o; o.x = pk2(yo[0] * silu(bflo(gr.x)), yo[1] * silu(bfhi(gr.x))); o.y = pk2(yo[2] * silu(bflo(gr.y)), yo[3] * silu(bfhi(gr.y)));
            *(u32x2*)(sp.mixed + tok * 1024 + 512 + ch) = o;
        }
        asm volatile("s_waitcnt lgkmcnt(0)" ::: "memory");
    }
}

__device__ __forceinline__ int next_item(unsigned* ctr, LAS unsigned* slot) {
    __syncthreads();
    if (threadIdx.x == 0) *slot = atomicAdd(ctr, 1u);
    __syncthreads();
    return (int)*slot;
}

__device__ __forceinline__ void xbar(unsigned* ctl, unsigned k, unsigned x, unsigned nloc, unsigned nx) {
    asm volatile("s_waitcnt vmcnt(0)" ::: "memory");
    __syncthreads();
    if (threadIdx.x == 0) {
        const unsigned old = __hip_atomic_fetch_add(ctl + 2048 + 64 * x, 1u, __ATOMIC_RELAXED, __HIP_MEMORY_SCOPE_AGENT);
        if (old + 1u == nloc * (k + 1u)) {
            __builtin_amdgcn_fence(__ATOMIC_RELEASE, "agent");
            __hip_atomic_fetch_add(ctl + 3072, 1u, __ATOMIC_RELAXED, __HIP_MEMORY_SCOPE_AGENT);
        }
        const unsigned target = nx * (k + 1u);
        while (__hip_atomic_load(ctl + 3072, __ATOMIC_RELAXED, __HIP_MEMORY_SCOPE_AGENT) < target) __builtin_amdgcn_s_sleep(1);
    }
    __syncthreads();
    __builtin_amdgcn_fence(__ATOMIC_ACQUIRE, "agent");
    asm volatile("s_waitcnt vmcnt(0)" ::: "memory");
}

__global__ void __launch_bounds__(512) hymba_fwd(Args a) {
    extern __shared__ __attribute__((aligned(16))) unsigned char lds_raw[];
    LAS unsigned char* lds = (LAS unsigned char*)lds_raw;
    LAS unsigned* qslot = (LAS unsigned*)(lds + QSLOT_OFF);
#define WSPTRS unsigned char* ws_ = a.ws; asm volatile("" : "+s"(ws_)); unsigned* ctl = (unsigned*)(ws_ + WS_CTL); bf16_t* WtIn = (bf16_t*)(ws_ + WS_WIN); bf16_t* WtOut = (bf16_t*)(ws_ + WS_WOUT); \
    bf16_t* hb = (bf16_t*)(ws_ + WS_HB); bf16_t* proj = (bf16_t*)(ws_ + WS_PROJ); float* misc = (float*)(ws_ + WS_MISC); \
    bf16_t* mixed = (bf16_t*)(ws_ + WS_MIXED); float* hss = (float*)(ws_ + WS_HSS); const float* biasT = (const float*)(ws_ + WS_BIAS); float* outp = a.out; asm volatile("" : "+s"(outp)); \
    (void)ctl; (void)WtIn; (void)WtOut; (void)hb; (void)proj; (void)misc; (void)mixed; (void)hss; (void)biasT; (void)outp;
    const int lo = a.ph_lo, hi = a.ph_hi;
#define IN(k) (lo <= (k) && (k) < hi)
    unsigned nloc = 1, nxcd = 1;
    const unsigned xcc = (unsigned)__builtin_amdgcn_s_getreg((3 << 11) | 20) & 0xFu;
    if (threadIdx.x == 0) __hip_atomic_fetch_add((unsigned*)(a.ws + WS_CTL) + 1024 + 64 * xcc, 1u, __ATOMIC_RELAXED, __HIP_MEMORY_SCOPE_AGENT);
#define SEAM(k, bi) do { if (IN(k) && IN((k) + 1)) { if ((k) == 0) { cg::this_grid().sync(); \
            { unsigned* c_ = (unsigned*)(a.ws + WS_CTL) + 1024; nloc = (unsigned)__builtin_amdgcn_readfirstlane((int)__hip_atomic_load(c_ + 64 * xcc, __ATOMIC_RELAXED, __HIP_MEMORY_SCOPE_AGENT)); unsigned nx_ = 0; \
                for (int q_ = 0; q_ < 16; ++q_) nx_ += (__hip_atomic_load(c_ + 64 * q_, __ATOMIC_RELAXED, __HIP_MEMORY_SCOPE_AGENT) != 0u) ? 1u : 0u; nxcd = (unsigned)__builtin_amdgcn_readfirstlane((int)nx_); } } \
        else xbar((unsigned*)(a.ws + WS_CTL), (unsigned)(bi), xcc, nloc, nxcd); } } while (0)
    if (IN(0)) { prologue(a, lds); }
    SEAM(0, 0);
#pragma unroll 1
    for (int l = 0; l < 2; ++l) {
        const int pb = 1 + 5 * l;
        if (IN(pb)) for (int rep = 0; rep < REP1A; ++rep) {
            WSPTRS
            if (rep) cg::this_grid().sync();
            pg8::Gemm g{hb, WtIn + (size_t)l * NINP * 1024, NTOK, NCD, 1024}; pg8::StaticOrder S; S.init(NTOK, NCD, gridDim.x, (int)blockIdx.x);
            pg8::EpiIn E{proj, misc, hss, 16};
            pg8::gemm_phase<pg8::EpiIn, pg8::StaticOrder, true, true>(lds, g, S, E);
        }
        SEAM(pb, 6 * l + 0);
        if (IN(pb + 1)) {
            WSPTRS
            ScanP sp{proj, mixed, misc, a.rwkv_mu + l * 1600, a.rwkv_w_up + l * 32 * 512, a.rwkv_w0 + l * 512, a.rwkv_a_up + l * 32 * 512, a.rwkv_a0 + l * 512,
                     a.rwkv_kkr + l * 3 * 512, a.rwkv_ln_gain + l * 512, a.rwkv_ln_bias + l * 512, a.out_gain + l * 2048,
                     (bf16_t*)(ws_ + WS_Q), (float*)(ws_ + WS_BON), (float*)(ws_ + WS_HE), (float*)(ws_ + WS_PE)};
            AttnP ap{proj, mixed, misc, a.qk_gain + l * 256, a.out_gain + l * 2048, biasT, a.forget_bias + l * 8, 0.f, 0.f};
            for (;;) {
                const int idx = next_item(ctl + pb + 1, qslot);
                if (idx >= 256 + 1024) break;
                if (idx < 256) {
#ifndef DIS_S
                    scan_pass1(sp, idx >> 5, (idx >> 2) & 7, idx & 3, lds);
#endif
                } else {
                    const int ci = idx - 256, qb = 15 - (ci >> 6), bh = ci & 63;
#ifndef DIS_C
                    attn_item<2>(ap, bh >> 3, bh & 7, qb, lds);
#endif
                }
            }
            xbar(ctl, (unsigned)(6 * l + 1), xcc, nloc, nxcd);
            for (;;) {
                const int idx = next_item(ctl + 32 + pb + 1, qslot);
                if (idx >= 256) break;
                if (idx < 256) {
#ifndef DIS_S
                    scan_pass2(sp, idx >> 5, (idx >> 2) & 7, idx & 3, lds);
#endif
                } else {
                    const int ci = 768 + idx - 256, qb = 15 - (ci >> 6), bh = ci & 63;
#ifndef DIS_C
                    attn_item<2>(ap, bh >> 3, bh & 7, qb, lds);
#endif
                }
            }
        }
        SEAM(pb + 1, 6 * l + 2);
        if (IN(pb + 2)) {
            WSPTRS
            {
                pg8::Gemm g{hb, WtIn + (size_t)l * NINP * 1024 + (size_t)NCD * 1024, NTOK, 4096, 1024}; pg8::StaticOrder S; S.init(NTOK, 4096, gridDim.x, (int)blockIdx.x);
                pg8::EpiIn E{proj, misc, hss, 16};
                pg8::gemm_phase<pg8::EpiIn, pg8::StaticOrder, true, true>(lds, g, S, E);
            }
            {
                pg8::Gemm g{mixed, WtOut + (size_t)(2 * l) * 1024 * 1024, NTOK, 1024, 1024}; pg8::StaticOrder S; S.init(NTOK, 1024, gridDim.x, (int)blockIdx.x);
                pg8::EpiOut E{l == 0 ? a.x : outp, outp, hb, hss, 0};
                pg8::gemm_phase<pg8::EpiOut, pg8::StaticOrder, true, true>(lds, g, S, E);
            }
        }
        SEAM(pb + 2, 6 * l + 3);
        if (IN(pb + 3)) for (int rep = 0; rep < REP2B; ++rep) {
            WSPTRS
            if (rep) cg::this_grid().sync();
            float lam;
            {
                const float* dl = a.diff_lambda + l * 256; int tl_ = threadIdx.x; asm volatile("" : "+v"(tl_)); const int lane = tl_ & 63;
                const float s1 = wave_sum(dl[lane] * dl[64 + lane]), s2 = wave_sum(dl[128 + lane] * dl[192 + lane]);
                const float lam_init = 0.8f - 0.6f * expf(-0.3f * (float)l);
                lam = expf(s1) - expf(s2) + lam_init;
                const float lam_u = __int_as_float(__builtin_amdgcn_readfirstlane(__float_as_int(lam))), oml_u = __int_as_float(__builtin_amdgcn_readfirstlane(__float_as_int(1.0f - lam_init)));
                AttnP ap{proj, mixed, misc, a.qk_gain + l * 256, a.out_gain + l * 2048, biasT, a.forget_bias + l * 8, lam_u, oml_u};
                for (;;) {
                    const int idx = next_item(ctl + pb + 3 + 16 * rep, qslot);
                    if (idx >= 1536) break;
                    if (idx < 512) { const int qb = 15 - (idx >> 5), bh = idx & 31;
#ifndef DIS_A
 attn_item<0>(ap, bh >> 2, bh & 3, qb, lds);
#endif
 }
                    else { const int i2 = idx - 512, qb = 15 - (i2 >> 6), bh = i2 & 63;
#ifndef DIS_B
 attn_item<1>(ap, bh >> 3, bh & 7, qb, lds);
#endif
 }
                }
            }
        }
        SEAM(pb + 3, 6 * l + 4);
        if (IN(pb + 4)) {
            WSPTRS
            pg8::Gemm g{mixed, WtOut + (size_t)(2 * l + 1) * 1024 * 1024, NTOK, 1024, 1024}; pg8::StaticOrder S; S.init(NTOK, 1024, gridDim.x, (int)blockIdx.x);
            pg8::EpiOut E{outp, outp, hb, hss, l == 0 ? 1 : 0};
            pg8::gemm_phase<pg8::EpiOut, pg8::StaticOrder, true, true>(lds, g, S, E);
        }
        if (l == 0) SEAM(pb + 4, 6 * l + 5);
    }
#undef IN
#undef SEAM
}

extern "C" void kernel_launch(void* const* d_in, const int* in_sizes, int n_in, void* d_out, int out_size, void* d_ws, size_t ws_size, hipStream_t stream) {
    static int grid = 0;
    if (grid == 0) {
        if (n_in != 17 || ws_size < WS_END) { fprintf(stderr, "kernel_launch: unexpected inputs (n_in %d, ws %zu < %zu)\n", n_in, ws_size, (size_t)WS_END); grid = -1; return; }
        int dev = 0, cus = 0, per_cu = 0;
        hipGetDevice(&dev); hipDeviceGetAttribute(&cus, hipDeviceAttributeMultiprocessorCount, dev);
        if (hipFuncSetAttribute((const void*)hymba_fwd, hipFuncAttributeMaxDynamicSharedMemorySize, LDS_BYTES) != hipSuccess) { fprintf(stderr, "kernel_launch: hipFuncSetAttribute failed\n"); grid = -1; return; }
        hipOccupancyMaxActiveBlocksPerMultiprocessor(&per_cu, (const void*)hymba_fwd, 512, LDS_BYTES);
        if (per_cu < 1) per_cu = 1;
        (void)hipGetLastError();
        grid = cus * 1;
        if (grid > 256) grid = 256;
    }
    if (grid < 0) return;
    hipMemsetAsync((char*)d_ws + WS_CTL, 0, 16384, stream);
    Args a{};
    a.x = (const float*)d_in[0]; a.norm_gain = (const float*)d_in[1]; a.w_in = (const float*)d_in[2]; a.w_out = (const float*)d_in[3]; a.rel_bias = (const float*)d_in[4];
    a.qk_gain = (const float*)d_in[5]; a.diff_lambda = (const float*)d_in[6]; a.forget_bias = (const float*)d_in[7]; a.out_gain = (const float*)d_in[8]; a.rwkv_mu = (const float*)d_in[9];
    a.rwkv_w_up = (const float*)d_in[10]; a.rwkv_w0 = (const float*)d_in[11]; a.rwkv_a_up = (const float*)d_in[12]; a.rwkv_a0 = (const float*)d_in[13]; a.rwkv_kkr = (const float*)d_in[14];
    a.rwkv_ln_gain = (const float*)d_in[15]; a.rwkv_ln_bias = (const float*)d_in[16];
    a.out = (float*)d_out; a.ws = (unsigned char*)d_ws;
#if MK_PER_PHASE
    for (int ph = 0; ph < 11; ++ph) { a.ph_lo = ph; a.ph_hi = ph + 1; hipLaunchKernelGGL(hymba_fwd, dim3(grid), dim3(512), LDS_BYTES, stream, a); }
#else
    a.ph_lo = 0; a.ph_hi = 11;
    void* args[] = {&a};
    hipError_t e = hipLaunchCooperativeKernel((const void*)hymba_fwd, dim3(grid), dim3(512), args, LDS_BYTES, stream);
    if (e != hipSuccess) fprintf(stderr, "cooperative launch failed: %s (grid %d)\n", hipGetErrorString(e), grid);
#endif
}
```

```cpp
#include <hip/hip_runtime.h>
#include <hip/hip_cooperative_groups.h>
#include <cstdio>
#include <cstdint>
namespace cg = cooperative_groups;

#ifndef MK_PER_PHASE
#define MK_PER_PHASE 0
#endif

#ifndef REP1A
#define REP1A 1
#endif
#ifndef REP2A
#define REP2A 1
#endif
#ifndef REP2B
#define REP2B 1
#endif
namespace pg8 {
#define PG8_LAS __attribute__((address_space(3)))
typedef unsigned short bf16_t;
typedef short bf16x8 __attribute__((ext_vector_type(8)));
typedef float f32x4 __attribute__((ext_vector_type(4)));
typedef unsigned u32x4 __attribute__((ext_vector_type(4)));
constexpr int BM = 256, BK = 64, HALF = 128, HTB = HALF * BK * 2  , STAGE_BYTES = 8 * HTB, NXCD = 8, WGM = 8;

__host__ __device__ __forceinline__ int lds_byte(int r, int c) { const int st = (r >> 4) * 2 + (c >> 5), rr = r & 15, cc = c & 31, ob = rr * 64 + cc * 2; return st * 1024 + (ob ^ (((ob >> 9) & 1) << 5)); }
__host__ __device__ __forceinline__ void stage_rc(int b, int& R, int& C) { const int st = b / 1024, sb = b % 1024, swz = sb ^ (((sb >> 9) & 1) << 5); R = (st >> 1) * 16 + swz / 64; C = (st & 1) * 32 + (swz % 64) / 2; }
__host__ __device__ __forceinline__ int perm32(int rho) { const int n = rho >> 4, i = rho & 15; return 8 * (i >> 2) + 4 * n + (i & 3); }

struct Unit { int pm, pn; };
struct Gemm { const bf16_t* A; const bf16_t* Bt; int M, N, K; };

struct StaticOrder {
    int nM, nN, nwg, G, c;
    __host__ __device__ void init(int M, int N, int G_, int c_) { nM = M / BM; nN = N / BM; nwg = nM * nN; G = G_; c = c_; }
    __host__ __device__ bool next(int i, Unit& u) const {
        const long L = (long)i * G + c; if (L >= nwg) return false;
        int wgid = (int)L; { const int q = nwg / NXCD, r = nwg % NXCD, xcd = wgid % NXCD, off = wgid / NXCD; wgid = (xcd < r ? xcd * (q + 1) : r * (q + 1) + (xcd - r) * q) + off; }
        const int nig = WGM * nN, gid = wgid / nig, fm = gid * WGM, gsz = (nM - fm) < WGM ? (nM - fm) : WGM;
        u.pm = fm + ((wgid % nig) % gsz); u.pn = (wgid % nig) / gsz; return true;
    }
    __device__ __forceinline__ void a_ready(const Unit&) const {}
    __device__ __forceinline__ void done(const Unit&) const {}
};

__device__ __forceinline__ unsigned cvt_pk_bf16(float lo, float hi) { unsigned r; asm volatile("v_cvt_pk_bf16_f32 %0, %1, %2" : "=v"(r) : "v"(lo), "v"(hi)); return r; }
typedef float f32x2 __attribute__((ext_vector_type(2)));

typedef unsigned u32x2 __attribute__((ext_vector_type(2)));
struct EpiIn {
    static constexpr bool PERM = true, AFTER_DRAIN = false;
    bf16_t* P; float* misc; const float* hss; int ntile_main;
    __device__ __forceinline__ void operator()(const f32x4 (&acc)[2][2][4][2], const Unit& u, int wr, int wc, int fr, int fq) const {
        const int row0 = u.pm * BM + wr * 64 + fr;
        float rsv[2][4];
#pragma unroll
        for (int ai = 0; ai < 2; ++ai) {
#pragma unroll
            for (int m = 0; m < 4; ++m) {
                const int row = row0 + ai * HALF + m * 16;
                const f32x4 h0 = *((const f32x4*)(hss + (size_t)row * 16) + fq);
                float ss = (h0[0] + h0[1]) + (h0[2] + h0[3]);
                ss += __shfl_xor(ss, 16); ss += __shfl_xor(ss, 32);
                rsv[ai][m] = 1.0f / sqrtf(ss * (1.0f / 1024.0f) + 1e-6f);
            }
            asm volatile("" ::: "memory");
        }
#pragma unroll
        for (int ai = 0; ai < 2; ++ai)
#pragma unroll
            for (int m = 0; m < 4; ++m) {
                const int row = row0 + ai * HALF + m * 16;
                const float rs = rsv[ai][m];
                if (u.pn < ntile_main) {
                    bf16_t* rowp = P + (size_t)row * 4160 + u.pn * BM + wc * 32 + 8 * fq;
#pragma unroll
                    for (int bj = 0; bj < 2; ++bj) {
                        const f32x4 v0 = acc[ai][bj][m][0] * rs, v1 = acc[ai][bj][m][1] * rs;
                        u32x4 w; w.x = cvt_pk_bf16(v0[0], v0[1]); w.y = cvt_pk_bf16(v0[2], v0[3]); w.z = cvt_pk_bf16(v1[0], v1[1]); w.w = cvt_pk_bf16(v1[2], v1[3]);
                        *(u32x4*)(rowp + bj * HALF) = w;
                    }
                } else {
                    const int c0 = wc * 32 + 8 * fq;
                    if (c0 < 72) {
                        *(f32x4*)(misc + (size_t)row * 80 + c0) = acc[ai][0][m][0] * rs;
                        *(f32x4*)(misc + (size_t)row * 80 + c0 + 4) = acc[ai][0][m][1] * rs;
                    }
                }
                asm volatile("" ::: "memory");
            }
    }
};
struct EpiOut {
    static constexpr bool PERM = false, AFTER_DRAIN = false;
    const float* res; float* out; bf16_t* hb; float* hss; int write_hb;
    __device__ __forceinline__ void operator()(const f32x4 (&acc)[2][2][4][2], const Unit& u, int wr, int wc, int fr, int fq) const {
        const int col0 = u.pn * BM + wc * 32 + 4 * fq;
#pragma unroll
        for (int ai = 0; ai < 2; ++ai)
#pragma unroll
            for (int m = 0; m < 4; ++m) {
                const int row = u.pm * BM + ai * HALF + wr * 64 + m * 16 + fr;
                const size_t off = (size_t)row * 1024 + col0;
                float ss = 0.f;
#pragma unroll
                for (int bj = 0; bj < 2; ++bj)
#pragma unroll
                    for (int n = 0; n < 2; ++n) {
                        const f32x4 o = *(const f32x4*)(res + off + bj * HALF + n * 16) + acc[ai][bj][m][n];
                        *(f32x4*)(out + off + bj * HALF + n * 16) = o;
                        if (write_hb) {
                            u32x2 w; w.x = cvt_pk_bf16(o[0], o[1]); w.y = cvt_pk_bf16(o[2], o[3]);
                            *(u32x2*)(hb + off + bj * HALF + n * 16) = w;
                            ss += (o[0] * o[0] + o[1] * o[1]) + (o[2] * o[2] + o[3] * o[3]);
                        }
                    }
                if (write_hb) {
                    ss += __shfl_xor(ss, 16); ss += __shfl_xor(ss, 32);
                    if (fq == 0) hss[(size_t)row * 16 + u.pn * 4 + wc] = ss;
                }
                if (m & 1) asm volatile("" ::: "memory");
            }
    }
};

template <class Epi, class Sched, bool ALIGN_EPI = false, bool SP2 = false>
__device__ __forceinline__ void gemm_phase(PG8_LAS unsigned char* lds, const Gemm g, const Sched& S, const Epi& E) {
    int tid_ = threadIdx.x; asm volatile("" : "+v"(tid_));
    const int tid = tid_, wid = __builtin_amdgcn_readfirstlane(tid >> 6), lane = tid & 63, wr = wid >> 2, wc = wid & 3, fr = lane & 15, fq = lane >> 4;
    const int K = g.K, nt = K / BK;
    unsigned voffA[2], voffB[2];
#pragma unroll
    for (int i = 0; i < 2; ++i) { int R, C; stage_rc(tid * 16 + i * 8192, R, C); const int Rb = Epi::PERM ? ((R & ~31) + perm32(R & 31)) : R;
        voffA[i] = (unsigned)(R * K + C) * 2u; voffB[i] = (unsigned)(Rb * K + C) * 2u; }
    const size_t kstep = (size_t)(BK * 2);
    const size_t hstep = (size_t)HALF * K * 2;
    const size_t tstep = 2 * hstep;
    const unsigned ldsw = (unsigned)wid * 1024u;
    const int aoff = lds_byte(wr * 64 + fr, fq * 8), boff = lds_byte(wc * 32 + fr, fq * 8);
#define PG8_SA(b, h) (((b) * 2 + (h)) * HTB)
#define PG8_SB(b, h) ((4 + (b) * 2 + (h)) * HTB)
#define PG8_STAGE(bufoff, gbase, voff) do { _Pragma("unroll") for (int _i = 0; _i < 2; ++_i) \
        __builtin_amdgcn_global_load_lds((const unsigned*)((const char*)(gbase) + (voff)[_i]), (PG8_LAS unsigned*)(lds + (bufoff) + ldsw + _i * 8192), 16, 0, 0); } while (0)
#define PG8_LDA(dst, b, h) do { _Pragma("unroll") for (int m = 0; m < 4; ++m) _Pragma("unroll") for (int k = 0; k < 2; ++k) dst[m][k] = *(const PG8_LAS bf16x8*)(lds + PG8_SA(b, h) + aoff + m * 2048 + k * 1024); } while (0)
#define PG8_LDB(dst, b, h) do { _Pragma("unroll") for (int n = 0; n < 2; ++n) _Pragma("unroll") for (int k = 0; k < 2; ++k) dst[n][k] = *(const PG8_LAS bf16x8*)(lds + PG8_SB(b, h) + boff + n * 2048 + k * 1024); } while (0)
#define PG8_MMA(ai, bj, At, Bt) do { __builtin_amdgcn_s_setprio(1); _Pragma("unroll") for (int m = 0; m < 4; ++m) _Pragma("unroll") for (int n = 0; n < 2; ++n) _Pragma("unroll") for (int k = 0; k < 2; ++k) \
        acc[ai][bj][m][n] = __builtin_amdgcn_mfma_f32_16x16x32_bf16(Bt[n][k], At[m][k], acc[ai][bj][m][n], 0, 0, 0); __builtin_amdgcn_s_setprio(0); } while (0)
#define PG8_WAIT_V(n) asm volatile("s_waitcnt vmcnt(" #n ")" ::: "memory")
#define PG8_WAIT_L(n) asm volatile("s_waitcnt lgkmcnt(" #n ")" ::: "memory")
#define PG8_BAR __builtin_amdgcn_s_barrier()
#define PG8_SCHED __builtin_amdgcn_sched_barrier(0)
    Unit cur, nxt; int ui = 0;
    if (!S.next(0, cur)) return;
    f32x4 acc[2][2][4][2];
#pragma unroll
    for (int a = 0; a < 2; ++a)
#pragma unroll
        for (int b = 0; b < 2; ++b)
#pragma unroll
            for (int m = 0; m < 4; ++m)
#pragma unroll
                for (int n = 0; n < 2; ++n) acc[a][b][m][n] = (f32x4){0.f, 0.f, 0.f, 0.f};
    bf16x8 At[4][2], B0[2][2], B1[2][2];
    const char* cA = (const char*)g.A + (size_t)cur.pm * tstep; const char* cB = (const char*)g.Bt + (size_t)cur.pn * tstep;
    S.a_ready(cur);
    if constexpr (SP2) {
        PG8_STAGE(PG8_SB(0, 0), cB, voffB); PG8_STAGE(PG8_SB(0, 1), cB + hstep, voffB); PG8_STAGE(PG8_SA(0, 0), cA, voffA); PG8_STAGE(PG8_SA(0, 1), cA + hstep, voffA);
        if (wr == 1) PG8_BAR;
        PG8_WAIT_V(2); PG8_BAR;
        PG8_STAGE(PG8_SB(1, 0), cB + kstep, voffB); PG8_STAGE(PG8_SA(1, 0), cA + kstep, voffA); PG8_STAGE(PG8_SB(1, 1), cB + hstep + kstep, voffB);
        PG8_WAIT_V(6); PG8_BAR;
    } else {
        PG8_STAGE(PG8_SB(0, 0), cB, voffB); PG8_STAGE(PG8_SA(0, 0), cA, voffA); PG8_STAGE(PG8_SB(0, 1), cB + hstep, voffB); PG8_STAGE(PG8_SA(0, 1), cA + hstep, voffA);
        if (wr == 1) PG8_BAR;
        PG8_WAIT_V(4); PG8_BAR;
        PG8_STAGE(PG8_SB(1, 0), cB + kstep, voffB); PG8_STAGE(PG8_SA(1, 0), cA + kstep, voffA); PG8_STAGE(PG8_SB(1, 1), cB + hstep + kstep, voffB);
        PG8_WAIT_V(6); PG8_BAR;
    }
    for (;;) {
        const bool has_next = S.next(ui + 1, nxt);
        const char* nA = has_next ? (const char*)g.A + (size_t)nxt.pm * tstep : cA; const char* nB = has_next ? (const char*)g.Bt + (size_t)nxt.pn * tstep : cB;
        for (int t = 0; t < nt; t += 2) {
            const bool last = (t == nt - 2);
            const char* a1 = cA + (size_t)(t + 1) * kstep;
            const char* a2 = last ? nA : cA + (size_t)(t + 2) * kstep; const char* b2 = last ? nB : cB + (size_t)(t + 2) * kstep;
            const char* a3 = a2 + kstep; const char* b3 = b2 + kstep;
            if (last && has_next) S.a_ready(nxt);
            if constexpr (SP2) {
            PG8_LDB(B0, 0, 0); PG8_LDB(B1, 0, 1); PG8_SCHED; PG8_LDA(At, 0, 0); PG8_STAGE(PG8_SA(1, 1), a1 + hstep, voffA);
            PG8_WAIT_V(8); PG8_WAIT_L(0); PG8_BAR; PG8_MMA(0, 0, At, B0); PG8_MMA(0, 1, At, B1); PG8_BAR; PG8_SCHED;
            PG8_LDA(At, 0, 1); PG8_STAGE(PG8_SB(0, 0), b2, voffB); PG8_STAGE(PG8_SB(0, 1), b2 + hstep, voffB); PG8_STAGE(PG8_SA(0, 0), a2, voffA);
            PG8_WAIT_V(8); PG8_WAIT_L(0); PG8_BAR; PG8_MMA(1, 0, At, B0); PG8_MMA(1, 1, At, B1); PG8_BAR; PG8_SCHED;
            PG8_LDB(B0, 1, 0); PG8_LDB(B1, 1, 1); PG8_SCHED; PG8_LDA(At, 1, 0); PG8_STAGE(PG8_SA(0, 1), a2 + hstep, voffA);
            PG8_WAIT_V(8); PG8_WAIT_L(0); PG8_BAR; PG8_MMA(0, 0, At, B0); PG8_MMA(0, 1, At, B1); PG8_BAR; PG8_SCHED;
            PG8_LDA(At, 1, 1); PG8_STAGE(PG8_SB(1, 0), b3, voffB); PG8_STAGE(PG8_SB(1, 1), b3 + hstep, voffB); PG8_STAGE(PG8_SA(1, 0), a3, voffA);
            PG8_WAIT_V(8); PG8_WAIT_L(0); PG8_BAR; PG8_MMA(1, 0, At, B0); PG8_MMA(1, 1, At, B1); PG8_BAR; PG8_SCHED;
            } else {
            PG8_LDB(B0, 0, 0); PG8_SCHED; PG8_LDA(At, 0, 0); PG8_STAGE(PG8_SA(1, 1), a1 + hstep, voffA);
            PG8_WAIT_L(8); PG8_BAR; PG8_WAIT_L(0); PG8_MMA(0, 0, At, B0); PG8_BAR; PG8_SCHED;
            PG8_LDB(B1, 0, 1); PG8_STAGE(PG8_SB(0, 0), b2, voffB);
            PG8_BAR; PG8_WAIT_L(0); PG8_MMA(0, 1, At, B1); PG8_BAR;
            PG8_LDA(At, 0, 1); PG8_STAGE(PG8_SA(0, 0), a2, voffA);
            PG8_BAR; PG8_WAIT_L(0); PG8_MMA(1, 0, At, B0); PG8_BAR; PG8_SCHED;
            PG8_STAGE(PG8_SB(0, 1), b2 + hstep, voffB);
            PG8_WAIT_V(6); PG8_BAR; PG8_MMA(1, 1, At, B1); PG8_BAR;
            PG8_LDB(B0, 1, 0); PG8_SCHED; PG8_LDA(At, 1, 0); PG8_STAGE(PG8_SA(0, 1), a2 + hstep, voffA);
            PG8_WAIT_L(8); PG8_BAR; PG8_WAIT_L(0); PG8_MMA(0, 0, At, B0); PG8_BAR; PG8_SCHED;
            PG8_LDB(B1, 1, 1); PG8_STAGE(PG8_SB(1, 0), b3, voffB);
            PG8_BAR; PG8_WAIT_L(0); PG8_MMA(0, 1, At, B1); PG8_BAR;
            PG8_LDA(At, 1, 1); PG8_STAGE(PG8_SA(1, 0), a3, voffA);
            PG8_BAR; PG8_WAIT_L(0); PG8_MMA(1, 0, At, B0); PG8_BAR; PG8_SCHED;
            PG8_STAGE(PG8_SB(1, 1), b3 + hstep, voffB);
            PG8_WAIT_V(6); PG8_BAR; PG8_MMA(1, 1, At, B1); PG8_BAR;
            }
        }
        if constexpr (ALIGN_EPI) { if (wr == 0) PG8_BAR; }
        if constexpr (!Epi::AFTER_DRAIN) { E(acc, cur, wr, wc, fr, fq); S.done(cur); }
        if (!has_next) break;
#pragma unroll
        for (int a = 0; a < 2; ++a)
#pragma unroll
            for (int b = 0; b < 2; ++b)
#pragma unroll
                for (int m = 0; m < 4; ++m)
#pragma unroll
                    for (int n = 0; n < 2; ++n) acc[a][b][m][n] = (f32x4){0.f, 0.f, 0.f, 0.f};
        cur = nxt; cA = nA; cB = nB; ++ui;
        if constexpr (ALIGN_EPI) { if (wr == 1) PG8_BAR; }
    }
    PG8_WAIT_V(0);
    if constexpr (!ALIGN_EPI) { if (wr == 0) PG8_BAR; }
    PG8_BAR;
    if constexpr (Epi::AFTER_DRAIN) { E.fused(acc, cur, wr, wc, fr, fq, lds, wid, lane); S.done(cur); }
#undef PG8_SA
#undef PG8_SB
#undef PG8_STAGE
#undef PG8_LDA
#undef PG8_LDB
#undef PG8_MMA
#undef PG8_WAIT_V
#undef PG8_WAIT_L
#undef PG8_BAR
#undef PG8_SCHED
}
}

#define LAS __attribute__((address_space(3)))
typedef unsigned short bf16_t;
typedef short bf16x8 __attribute__((ext_vector_type(8)));
typedef short s16x4 __attribute__((ext_vector_type(4)));
typedef float f32x4 __attribute__((ext_vector_type(4)));
typedef float f32x2 __attribute__((ext_vector_type(2)));
typedef float f32x16 __attribute__((ext_vector_type(16)));
typedef unsigned u32x4 __attribute__((ext_vector_type(4)));
typedef unsigned u32x2 __attribute__((ext_vector_type(2)));
typedef __bf16 bf16x2_t __attribute__((ext_vector_type(2)));
#define MFMA32(a, b, c) __builtin_amdgcn_mfma_f32_32x32x16_bf16((a), (b), (c), 0, 0, 0)

constexpr int NTOK = 32768, DM = 1024, SEQ = 4096, NIN = 8264, NINP = 8448, NCD = 4352, PP = 4160, MISCP = 80;
constexpr float LOG2E = 1.4426950408889634f;
constexpr size_t WS_CTL = 0, WS_BIAS = 16384, WS_WIN = 1u << 20, WS_WOUT = WS_WIN + (size_t)2 * NINP * 1024 * 2, WS_HB = WS_WOUT + (size_t)4 * 1024 * 1024 * 2,
                 WS_PROJ = WS_HB + (size_t)NTOK * 1024 * 2, WS_MISC = WS_PROJ + (size_t)NTOK * PP * 2, WS_MIXED = WS_MISC + (size_t)NTOK * MISCP * 4,
                 WS_HSS = WS_MIXED + (size_t)NTOK * 1024 * 2, WS_Q = WS_HSS + (size_t)NTOK * 16 * 4, WS_BON = WS_Q + (size_t)NTOK * 512 * 2,
                 WS_HE = WS_BON + (size_t)NTOK * 8 * 4, WS_PE = WS_HE + (size_t)256 * 4096 * 4, WS_END = WS_PE + (size_t)256 * 4096 * 4;
constexpr int QSLOT_OFF = 143360, LDS_BYTES = QSLOT_OFF + 1024;

__device__ __forceinline__ unsigned pk2(float lo, float hi) { f32x2 v = {lo, hi}; bf16x2_t b = __builtin_convertvector(v, bf16x2_t); return __builtin_bit_cast(unsigned, b); }
typedef short v4i16_t __attribute__((ext_vector_type(4)));
__device__ __forceinline__ s16x4 vtr(const LAS unsigned char* p) { return __builtin_bit_cast(s16x4, __builtin_amdgcn_ds_read_tr16_b64_v4i16((LAS v4i16_t*)p)); }
__device__ __forceinline__ float bflo(unsigned u) { return __uint_as_float(u << 16); }
__device__ __forceinline__ float bfhi(unsigned u) { return __uint_as_float(u & 0xffff0000u); }
__device__ __forceinline__ float ex2(float x) { return __builtin_amdgcn_exp2f(x); }
__device__ __forceinline__ float lg2(float x) { return __builtin_amdgcn_logf(x); }
__device__ __forceinline__ float wave_sum(float v) {
#pragma unroll
    for (int o = 1; o < 64; o <<= 1) v += __shfl_xor(v, o);
    return v;
}
__device__ __forceinline__ float dpp_xor1(float v) { return __int_as_float(__builtin_amdgcn_update_dpp(0, __float_as_int(v), 0xB1, 0xF, 0xF, true)); }
__device__ __forceinline__ float dpp_xor2(float v) { return __int_as_float(__builtin_amdgcn_update_dpp(0, __float_as_int(v), 0x4E, 0xF, 0xF, true)); }
__device__ __forceinline__ float dpp_hmir(float v) { return __int_as_float(__builtin_amdgcn_update_dpp(0, __float_as_int(v), 0x141, 0xF, 0xF, true)); }
__device__ __forceinline__ float red8(float v) { v += dpp_xor1(v); v += dpp_xor2(v); v += dpp_hmir(v); return v; }
__device__ __forceinline__ float silu(float g) { return g * __builtin_amdgcn_rcpf(1.0f + __expf(-g)); }

struct Args {
    const float *x, *norm_gain, *w_in, *w_out, *rel_bias, *qk_gain, *diff_lambda, *forget_bias, *out_gain, *rwkv_mu, *rwkv_w_up, *rwkv_w0, *rwkv_a_up, *rwkv_a0, *rwkv_kkr, *rwkv_ln_gain, *rwkv_ln_bias;
    float* out; unsigned char* ws; int ph_lo, ph_hi;
};

__device__ __forceinline__ int refcol_in(int np) {
    if (np < 2048) return 4096 + np;
    if (np < 3584) return 6152 + (np - 2048);
    if (np < 4096) return 7752 + (np - 3584);
    if (np < 4160) return 7688 + (np - 4096);
    if (np < 4168) return 6144 + (np - 4160);
    if (np < 4352) return -1;
    return np - 4352;
}
template <bool MAPPED>
__device__ __forceinline__ void transpose_item(const float* W, int ldw, const float* gain, bf16_t* WT, LAS float* scr, int kb, int nb, int lane) {
    const int k0 = 64 * kb, n0 = 32 * nb;
    int rc = n0 + (lane & 31);
    if (MAPPED) rc = refcol_in(rc);
    float tv_[32];
#pragma unroll
    for (int i = 0; i < 32; ++i) {
        const int kk = 2 * i + (lane >> 5);
        float v = 0.f;
        if (rc >= 0) { v = W[(size_t)(k0 + kk) * ldw + rc]; if (MAPPED) v *= gain[k0 + kk]; }
        tv_[i] = v;
    }
#pragma unroll
    for (int i = 0; i < 32; ++i) scr[(2 * i + (lane >> 5)) * 33 + (lane & 31)] = tv_[i];
    asm volatile("s_waitcnt lgkmcnt(0)" ::: "memory");
    const int c = lane & 7;
#pragma unroll
    for (int j = 0; j < 4; ++j) {
        const int n = (lane >> 3) + 8 * j; const LAS float* s = scr + (8 * c) * 33 + n;
        u32x4 o; o.x = pk2(s[0 * 33], s[1 * 33]); o.y = pk2(s[2 * 33], s[3 * 33]); o.z = pk2(s[4 * 33], s[5 * 33]); o.w = pk2(s[6 * 33], s[7 * 33]);
        *(u32x4*)(WT + (size_t)(n0 + n) * 1024 + k0 + 8 * c) = o;
    }
    asm volatile("s_waitcnt lgkmcnt(0)" ::: "memory");
}

__device__ __forceinline__ void prologue(const Args& a, LAS unsigned char* lds) {
    const int tid = threadIdx.x, lane = tid & 63, wave = tid >> 6;
    LAS float* scr = (LAS float*)(lds + wave * 8704);
    const int gw = blockIdx.x * 8 + wave, NGW = gridDim.x * 8;
    bf16_t* WtIn = (bf16_t*)(a.ws + WS_WIN); bf16_t* WtOut = (bf16_t*)(a.ws + WS_WOUT);
    constexpr int I_IN = 16 * (NINP / 32), I_OUT = 16 * 32;
    constexpr int NITEMS = 2 * I_IN + 4 * I_OUT;
    for (int it = gw; it < NITEMS; it += NGW) {
        if (it < 2 * I_IN) {
            const int l = it / I_IN, r = it % I_IN, kb = r / (NINP / 32), nb = r % (NINP / 32);
            transpose_item<true>(a.w_in + (size_t)l * 1024 * NIN, NIN, a.norm_gain + l * 1024, WtIn + (size_t)l * NINP * 1024, scr, kb, nb, lane);
        } else {
            const int r0 = it - 2 * I_IN, mi = r0 / I_OUT, r = r0 % I_OUT, kb = r / 32, nb = r % 32, l = mi >> 1, half = mi & 1;
            transpose_item<false>(a.w_out + (size_t)l * 2048 * 1024 + (size_t)(half == 0 ? 1024 : 0) * 1024, 1024, nullptr, WtOut + (size_t)mi * 1024 * 1024, scr, kb, nb, lane);
        }
    }
    bf16_t* hb = (bf16_t*)(a.ws + WS_HB); float* hss = (float*)(a.ws + WS_HSS);
    for (int m0 = gw * 4; m0 < NTOK; m0 += NGW * 4) {
        f32x4 v[4][4];
#pragma unroll
        for (int r = 0; r < 4; ++r) { const f32x4* xr = (const f32x4*)(a.x + (size_t)(m0 + r) * 1024) + lane;
#pragma unroll
            for (int j = 0; j < 4; ++j) v[r][j] = xr[64 * j]; }
#pragma unroll
        for (int r = 0; r < 4; ++r) {
            float s = 0.f;
#pragma unroll
            for (int j = 0; j < 4; ++j) s += (v[r][j][0] * v[r][j][0] + v[r][j][1] * v[r][j][1]) + (v[r][j][2] * v[r][j][2] + v[r][j][3] * v[r][j][3]);
            s = wave_sum(s);
            u32x2* o8 = (u32x2*)(hb + (size_t)(m0 + r) * 1024) + lane;
#pragma unroll
            for (int j = 0; j < 4; ++j) { u32x2 w; w.x = pk2(v[r][j][0], v[r][j][1]); w.y = pk2(v[r][j][2], v[r][j][3]); o8[64 * j] = w; }
            if (lane < 16) hss[(size_t)(m0 + r) * 16 + lane] = (lane == 0) ? s : 0.f;
        }
    }
    if (blockIdx.x == 0) {
        float* bt = (float*)(a.ws + WS_BIAS);
        for (int e = tid; e < 1024; e += 512) {
            const int h = e >> 8, d = e & 255;
            int bk;
            if (d < 16) bk = d;
            else { const float lg = logf((float)d / 16.0f) / 2.0794415416798357f * 16.0f; bk = 16 + (int)lg; if (bk > 31) bk = 31; }
            bt[e] = a.rel_bias[bk * 4 + h] * LOG2E;
        }
    }
}

struct AttnP {
    const bf16_t* P; bf16_t* mixed; const float* misc;
    const float* qk_gain;
    const float* out_gain;
    const float* biasT;
    const float* fbias;
    float lam, oml;
};
__device__ __forceinline__ int crow(int r, int hi) { return (r & 3) + 8 * (r >> 2) + 4 * hi; }

template <int MODE>
__device__ __forceinline__ void attn_item(const AttnP& p, int b, int h, int qb, LAS unsigned char* lds) {
    constexpr int NC = (MODE == 0) ? 2 : 1, DK = 64 * NC, DV = 64 * NC, KP = DK + 8, VPT = DV + 32;
    constexpr int KS_BYTES = 64 * KP * 2, VT_BYTES = 64 * VPT * 2, BUF_BYTES = KS_BYTES + VT_BYTES + 256;
    constexpr int TAB_OFF = 2 * BUF_BYTES, FLAG_OFF = TAB_OFF + 1024, QP_OFF = FLAG_OFF + 512;
    constexpr bool QPARK = (MODE == 0);
    int tid_ = threadIdx.x; asm volatile("" : "+v"(tid_));
    const int tid = tid_, lane = tid & 63, w = __builtin_amdgcn_readfirstlane(tid >> 6), hh = lane >> 5, ln = lane & 31;
    const int qcol = ((MODE == 1) ? 2048 : 0) + h * DK, kcol = qcol + 512, vcol = qcol + 1024, gcol = qcol + 1536;
    const int mixcol = ((MODE == 1) ? 512 : 0) + h * DV;
    const int gaincol = ((MODE == 0) ? 0 : (MODE == 1) ? 512 : 1024) + h * DV;
    const int tok0 = b * SEQ, q0 = qb * 256, qw = q0 + 32 * w, qrow = qw + ln;
    const bf16_t* P = p.P;

    bf16x8 Qf[NC][4];
#pragma unroll
    for (int c = 0; c < NC; ++c) {
        u32x4 raw[4]; float ss = 0.f;
#pragma unroll
        for (int ks = 0; ks < 4; ++ks) {
            raw[ks] = *(const u32x4*)(P + (size_t)(tok0 + qrow) * PP + qcol + c * 64 + ks * 16 + hh * 8);
#pragma unroll
            for (int e = 0; e < 4; ++e) { const float lo = bflo(raw[ks][e]), hi = bfhi(raw[ks][e]); ss += lo * lo + hi * hi; }
        }
        float sc = 0.125f * LOG2E;
        if (MODE != 1) { ss += __shfl_xor(ss, 32); sc *= 1.0f / sqrtf(ss * (1.0f / 64.0f) + 1e-6f); }
#pragma unroll
        for (int ks = 0; ks < 4; ++ks) {
            u32x4 o;
#pragma unroll
            for (int e = 0; e < 4; ++e) {
                float lo = bflo(raw[ks][e]) * sc, hi = bfhi(raw[ks][e]) * sc;
                if (MODE != 1) {
                    const int d = ks * 16 + hh * 8 + 2 * e;
                    const float* gq = p.qk_gain + ((MODE == 0) ? 0 : 128); const float* gk = gq + 64;
                    lo *= gq[d] * gk[d]; hi *= gq[d + 1] * gk[d + 1];
                }
                o[e] = pk2(lo, hi);
            }
            Qf[c][ks] = __builtin_bit_cast(bf16x8, o);
            if (QPARK) *(LAS u32x4*)(lds + QP_OFF + w * 8192 + ((c * 4 + ks) * 64 + lane) * 16) = o;
        }
    }
    if (MODE == 0) { LAS float* tab = (LAS float*)(lds + TAB_OFF); if (tid < 256) tab[tid] = p.biasT[h * 256 + tid]; }
    LAS unsigned* flags = (LAS unsigned*)(lds + FLAG_OFF);
    if (MODE == 1 && tid < 16) flags[tid] = 0u;

    f32x16 O[NC][DV / 32];
#pragma unroll
    for (int c = 0; c < NC; ++c)
#pragma unroll
        for (int d = 0; d < DV / 32; ++d)
#pragma unroll
            for (int i = 0; i < 16; ++i) O[c][d][i] = 0.f;
    float mrun[NC], lsum[NC];
#pragma unroll
    for (int c = 0; c < NC; ++c) { mrun[c] = -1e30f; lsum[c] = 0.f; }
    float R2 = 0.f; bool mydone = false;
    float carry = 0.f, bq0 = 0.f, qk2 = 0.f;
    LAS unsigned* cflags = flags + 32;
    if (MODE == 2) {
        if (tid < 4) cflags[tid] = 0u;
        float gq_ = fabsf(p.qk_gain[128 + lane]), gk_ = fabsf(p.qk_gain[192 + lane]);
#pragma unroll
        for (int o_ = 1; o_ < 64; o_ <<= 1) { gq_ = fmaxf(gq_, __shfl_xor(gq_, o_)); gk_ = fmaxf(gk_, __shfl_xor(gk_, o_)); }
        qk2 = 8.0f * gq_ * gk_ * LOG2E * 1.02f;
    }
    const float fb = (MODE == 2) ? p.fbias[h] : 0.f;

    const int jt_max = qb * 4 + 3;
    u32x4 kreg[NC], vreg[NC]; float cfreg = 0.f;
#define ATT_LOADK(jt) do { _Pragma("unroll") for (int i_ = 0; i_ < NC; ++i_) { const int key_ = tid >> 3, dch_ = (tid & 7) + 8 * i_; \
            const bf16_t* rp_ = P + (size_t)(tok0 + (jt) * 64 + key_) * PP + dch_ * 8; kreg[i_] = *(const u32x4*)(rp_ + kcol); } \
        if (MODE == 2 && w == 0) cfreg = p.misc[(size_t)(tok0 + (jt) * 64 + lane) * MISCP + 64 + h]; } while (0)
#define ATT_LOADV(jt) do { _Pragma("unroll") for (int i_ = 0; i_ < NC; ++i_) { const int key_ = tid >> 3, dch_ = (tid & 7) + 8 * i_; \
            const bf16_t* rp_ = P + (size_t)(tok0 + (jt) * 64 + key_) * PP + dch_ * 8; vreg[i_] = *(const u32x4*)(rp_ + vcol); } } while (0)
#define ATT_LOAD(jt) do { ATT_LOADK(jt); ATT_LOADV(jt); } while (0)
#define ATT_STORE(buf, T_) do { LAS unsigned char* kb_ = lds + (buf) * BUF_BYTES; LAS unsigned char* vb_ = kb_ + KS_BYTES; \
        _Pragma("unroll") for (int i_ = 0; i_ < NC; ++i_) { const int key_ = tid >> 3, dch_ = (tid & 7) + 8 * i_; \
            u32x4 kv_ = kreg[i_]; \
            if (MODE != 1) { float ss_ = 0.f; _Pragma("unroll") for (int e_ = 0; e_ < 4; ++e_) { const float lo_ = bflo(kv_[e_]), hi_ = bfhi(kv_[e_]); ss_ += lo_ * lo_ + hi_ * hi_; } \
                ss_ = red8(ss_); const float inv_ = __builtin_amdgcn_rsqf(ss_ * (1.0f / 64.0f) + 1e-6f); \
                _Pragma("unroll") for (int e_ = 0; e_ < 4; ++e_) kv_[e_] = pk2(bflo(kv_[e_]) * inv_, bfhi(kv_[e_]) * inv_); } \
            *(LAS u32x4*)(kb_ + (key_ * KP + dch_ * 8) * 2) = kv_; \
            const u32x4 vv_ = vreg[i_]; \
            *(LAS u32x4*)(vb_ + (key_ * VPT + dch_ * 8) * 2) = vv_; } \
        if (MODE == 2 && w == 0) { const float x_ = cfreg + fb; const float lf_ = fminf(x_, 0.f) - __logf(1.0f + __expf(-fabsf(x_))); float s_ = lf_; \
            _Pragma("unroll") for (int o_ = 1; o_ < 64; o_ <<= 1) { const float t_ = __shfl_down(s_, o_); if (lane + o_ < 64) s_ += t_; } \
            const float bval_ = (carry + (s_ - lf_)) * LOG2E; ((LAS float*)(vb_ + VT_BYTES))[lane] = bval_; carry += __shfl(s_, 0); \
            if ((T_) == 4 * qb) bq0 = __shfl(bval_, 0); \
            const bool ex_ = ((T_) <= 4 * qb) && (12.0f + 2.0f * qk2 + carry * LOG2E - bq0 < -32.0f); \
            if (lane == 0) cflags[(T_) & 3] = ex_ ? 1u : 0u; } } while (0)

    ATT_LOAD(jt_max);
    ATT_STORE(0, jt_max);
    __syncthreads();
    float mfix = 0.f;
    if (MODE == 2) mfix = qk2;
    if (MODE == 0) {
        float gq_ = fabsf(p.qk_gain[lane]), gk_ = fabsf(p.qk_gain[64 + lane]);
        const LAS float* tab_ = (const LAS float*)(lds + TAB_OFF);
        float tm_ = fmaxf(fmaxf(fabsf(tab_[lane]), fabsf(tab_[64 + lane])), fmaxf(fabsf(tab_[128 + lane]), fabsf(tab_[192 + lane])));
#pragma unroll
        for (int o_ = 1; o_ < 64; o_ <<= 1) { gq_ = fmaxf(gq_, __shfl_xor(gq_, o_)); gk_ = fmaxf(gk_, __shfl_xor(gk_, o_)); tm_ = fmaxf(tm_, __shfl_xor(tm_, o_)); }
        mfix = 8.0f * gq_ * gk_ * LOG2E * 1.02f + tm_;
    }
    for (int it = 0; it <= jt_max; ++it) {
        const int jt = jt_max - it, k0 = jt * 64, buf = it & 1;
        const bool has_next = it < jt_max;
        if (has_next) { ATT_LOADK(jt - 1); ATT_LOADV(jt - 1); }
        LAS unsigned char* ksb = lds + buf * BUF_BYTES; LAS unsigned char* vtb = ksb + KS_BYTES;
#pragma unroll
        for (int kb2 = 1; kb2 >= 0; --kb2) {
            const int kp0 = k0 + 32 * kb2;
            bool active = (MODE == 1) ? (kp0 <= qw + 30) : (kp0 <= qw + 31);
            if (MODE == 1) active = active && !mydone;
            if (active) {
                f32x16 S[NC];
#define ATT_QK(c, INIT) do { _Pragma("unroll") for (int i = 0; i < 16; ++i) S[c][i] = (INIT); \
                    _Pragma("unroll") for (int ks = 0; ks < 4; ++ks) { const bf16x8 ka = *(const LAS bf16x8*)(ksb + ((32 * kb2 + ln) * KP + (c) * 64 + ks * 16 + hh * 8) * 2); const bf16x8 qf_ = (QPARK && (c) == 1) ? *(const LAS bf16x8*)(lds + QP_OFF + w * 8192 + (((c) * 4 + ks) * 64 + lane) * 16) : Qf[(QPARK && (c) == 1) ? 0 : (c)][ks]; S[c] = MFMA32(ka, qf_, S[c]); } } while (0)
                if (MODE == 1) ATT_QK(0, 0.f);
                const bool need_mask = (MODE == 1) ? (kp0 + 31 >= qw) : (kp0 + 31 > qw);
                bf16x8 pb[NC][2];
                if (MODE == 1) {
                    float L2[16], z2[16];
#pragma unroll
                    for (int i = 0; i < 16; ++i) {
                        z2[i] = S[0][i];
                        const bool valid = !need_mask || (kp0 + crow(i, hh) < qrow);
                        const float sp = fmaxf(z2[i], 0.f) + lg2(1.0f + ex2(-fabsf(z2[i])));
                        L2[i] = valid ? -sp : 0.f;
                    }
                    float G[4], PG[4], ag[4];
#pragma unroll
                    for (int g = 0; g < 4; ++g) { G[g] = (L2[4 * g] + L2[4 * g + 1]) + (L2[4 * g + 2] + L2[4 * g + 3]); PG[g] = __shfl_xor(G[g], 32); }
                    float accg = 0.f;
#pragma unroll
                    for (int g = 3; g >= 0; --g) { ag[g] = accg + (hh == 0 ? PG[g] : 0.f); accg += G[g] + PG[g]; }
                    float A[16];
#pragma unroll
                    for (int g = 0; g < 4; ++g) {
                        const float base = R2 + ag[g];
                        const float w3 = 0.f, w2 = L2[4 * g + 3], w1 = w2 + L2[4 * g + 2], w0 = w1 + L2[4 * g + 1];
                        const float wi[4] = {w0, w1, w2, w3};
#pragma unroll
                        for (int e = 0; e < 4; ++e) {
                            const int i = 4 * g + e;
                            const bool valid = !need_mask || (kp0 + crow(i, hh) < qrow);
                            A[i] = valid ? ex2(z2[i] + L2[i] + base + wi[e]) : 0.f;
                        }
                    }
                    R2 += accg;
#pragma unroll
                    for (int t2 = 0; t2 < 2; ++t2) {
                        u32x4 o; o.x = pk2(A[8 * t2], A[8 * t2 + 1]); o.y = pk2(A[8 * t2 + 2], A[8 * t2 + 3]); o.z = pk2(A[8 * t2 + 4], A[8 * t2 + 5]); o.w = pk2(A[8 * t2 + 6], A[8 * t2 + 7]);
                        pb[0][t2] = __builtin_bit_cast(bf16x8, o);
                    }
                } else {
#define ATT_TAIL(c) do { float ps = 0.f; float pe[16]; _Pragma("unroll") for (int i = 0; i < 16; ++i) { pe[i] = ex2(S[c][i]); ps += pe[i]; } lsum[c] += ps; \
                        _Pragma("unroll") for (int t2 = 0; t2 < 2; ++t2) { u32x4 o; o.x = pk2(pe[8 * t2], pe[8 * t2 + 1]); o.y = pk2(pe[8 * t2 + 2], pe[8 * t2 + 3]); o.z = pk2(pe[8 * t2 + 4], pe[8 * t2 + 5]); o.w = pk2(pe[8 * t2 + 6], pe[8 * t2 + 7]); \
                            pb[c][t2] = __builtin_bit_cast(bf16x8, o); } } while (0)
                    if (MODE == 0) {
                        const LAS float* tab = (const LAS float*)(lds + TAB_OFF);
                        if (qw - (kp0 + 31) >= 128) {
                            const float cb = tab[255] - mfix;
#pragma unroll
                            for (int c = 0; c < NC; ++c) { ATT_QK(c, cb); ATT_TAIL(c); }
                        } else {
                            float binit[16];
#pragma unroll
                            for (int i = 0; i < 16; ++i) {
                                const int dist = qrow - (kp0 + crow(i, hh));
                                binit[i] = (dist < 0) ? -3e38f : (tab[dist > 255 ? 255 : dist] - mfix);
                            }
#pragma unroll
                            for (int c = 0; c < NC; ++c) { ATT_QK(c, binit[i]); ATT_TAIL(c); }
                        }
                    } else {
                        float binit[16];
                        const LAS float* bl = (const LAS float*)(vtb + VT_BYTES) + 32 * kb2 + 4 * hh;
#pragma unroll
                        for (int g = 0; g < 4; ++g) {
                            const f32x4 t = *(const LAS f32x4*)(bl + 8 * g);
#pragma unroll
                            for (int e = 0; e < 4; ++e) binit[4 * g + e] = (need_mask && (kp0 + crow(4 * g + e, hh) > qrow)) ? -3e38f : (t[e] - mfix);
                        }
                        ATT_QK(0, binit[i]); ATT_TAIL(0);
                    }
#undef ATT_TAIL
                }
#pragma unroll
                for (int t2 = 0; t2 < 2; ++t2)
#pragma unroll
                    for (int d = 0; d < DV / 32; ++d) {
                        const LAS unsigned char* vp = vtb + ((32 * kb2 + 16 * t2 + 4 * hh + ((lane & 15) >> 2)) * VPT + d * 32 + 16 * ((lane >> 4) & 1) + 4 * (lane & 3)) * 2;
                        const s16x4 lo = vtr(vp), hi = vtr(vp + 8 * VPT * 2);
                        const bf16x8 va = __builtin_shufflevector(lo, hi, 0, 1, 2, 3, 4, 5, 6, 7);
#pragma unroll
                        for (int c = 0; c < NC; ++c) O[c][d] = MFMA32(va, pb[c][t2], O[c][d]);
                    }
            }
        }
        if (MODE == 1) {
            if (!mydone && __all(R2 < -45.0f)) mydone = true;
            if (lane == 0) flags[(it & 1) * 8 + w] = mydone ? 1u : 0u;
        }
        if (has_next) { ATT_STORE(buf ^ 1, jt - 1); }
        __syncthreads();
        if (MODE == 2) { if (cflags[jt & 3]) break; }
        if (MODE == 1) {
            unsigned alld = 1u;
#pragma unroll
            for (int i = 0; i < 8; ++i) alld &= flags[(it & 1) * 8 + i];
            if (alld) break;
        }
    }
#undef ATT_LOAD
#undef ATT_LOADK
#undef ATT_LOADV
#undef ATT_STORE
    float inv0 = 1.f, inv1 = 0.f;
    if (MODE != 1) { float l0 = lsum[0]; l0 += __shfl_xor(l0, 32); inv0 = 1.0f / l0; }
    if (MODE == 0) { float l1 = lsum[NC - 1]; l1 += __shfl_xor(l1, 32); inv1 = p.lam / l1; }
    float ss = 0.f;
#pragma unroll
    for (int d = 0; d < DV / 32; ++d)
#pragma unroll
        for (int i = 0; i < 16; ++i) {
            float o = O[0][d][i] * inv0;
            if (MODE == 0) o -= O[NC - 1][d][i] * inv1;
            O[0][d][i] = o; ss += o * o;
        }
    ss += __shfl_xor(ss, 32);
    float rn = 1.0f / sqrtf(ss * (1.0f / DV) + 1e-6f);
    if (MODE == 0) rn *= p.oml;
    int qrow_e = qrow; asm volatile("" : "+v"(qrow_e));
    const size_t trow = (size_t)(tok0 + qrow_e);
#pragma unroll
    for (int d = 0; d < DV / 32; ++d)
#pragma unroll
        for (int g = 0; g < 4; ++g) {
            const int dd = d * 32 + 8 * g + 4 * hh;
            const u32x2 gr = *(const u32x2*)(P + trow * PP + gcol + dd);
            const f32x4 og = *(const f32x4*)(p.out_gain + gaincol + dd);
            const float o0 = O[0][d][4 * g] * rn * og[0] * silu(bflo(gr.x)), o1 = O[0][d][4 * g + 1] * rn * og[1] * silu(bfhi(gr.x));
            const float o2 = O[0][d][4 * g + 2] * rn * og[2] * silu(bflo(gr.y)), o3 = O[0][d][4 * g + 3] * rn * og[3] * silu(bfhi(gr.y));
            u32x2 wv; wv.x = pk2(o0, o1); wv.y = pk2(o2, o3);
            *(u32x2*)(p.mixed + trow * 1024 + mixcol + dd) = wv;
        }
}

struct ScanP {
    const bf16_t* P; bf16_t* mixed; const float* misc;
    const float *mu, *w_up, *w0, *a_up, *a0, *kkr, *ln_gain, *ln_bias, *out_gain;
    bf16_t* Q; float* bon; float* HE; float* PE;
};
__device__ __forceinline__ float red16(float v) { v = red8(v); v += __int_as_float(__builtin_amdgcn_update_dpp(0, __float_as_int(v), 0x140, 0xF, 0xF, true)); return v; }

__device__ __forceinline__ bf16x8 pack8(const f32x16& x, int s) {
    u32x4 o; o.x = pk2(x[8 * s], x[8 * s + 1]); o.y = pk2(x[8 * s + 2], x[8 * s + 3]); o.z = pk2(x[8 * s + 4], x[8 * s + 5]); o.w = pk2(x[8 * s + 6], x[8 * s + 7]);
    return __builtin_bit_cast(bf16x8, o);
}
__device__ __forceinline__ bf16x8 ld_krow(const LAS unsigned char* p) {
    const s16x4 lo = *(const LAS s16x4*)p, hi = *(const LAS s16x4*)(p + 16);
    return __builtin_shufflevector(lo, hi, 0, 1, 2, 3, 4, 5, 6, 7);
}
__device__ __forceinline__ void scan_pass1(const ScanP& sp, int b, int h, int seg, LAS unsigned char* lds) {
    int tid_ = threadIdx.x; asm volatile("" : "+v"(tid_));
    const int tid = tid_, lane = tid & 63, w = __builtin_amdgcn_readfirstlane(tid >> 6);
    constexpr int O_WUP = 0, O_AUP = 8192, O_LORA = 16384, O_LW = 24576, O_KK = 32768, O_R = 37376, O_K = 41984, O_B = 46592, O_KT = 51200, O_BT = 56320, O_VT = 61440,
                  O_MK = 66560, O_NK = 69120, O_TM = 71680, O_NB = 74240, O_NT = 76800, O_GAM = 80896, O_VV = 81152, O_SC = 89344, O_YB = 89856, O_N21 = 109056;
    LAS float* wup = (LAS float*)(lds + O_WUP); LAS float* aup = (LAS float*)(lds + O_AUP); LAS float* lora = (LAS float*)(lds + O_LORA); LAS float* lwS = (LAS float*)(lds + O_LW);
    LAS float* NT = (LAS float*)(lds + O_NT); LAS float* gam = (LAS float*)(lds + O_GAM); LAS float* vvv = (LAS float*)(lds + O_VV); LAS float* scl = (LAS float*)(lds + O_SC); LAS float* yb = (LAS float*)(lds + O_YB); LAS float* qb = (LAS float*)(lds + 100864);
    LAS float* stash = (LAS float*)(lds + 117248);
    const int tok0 = b * SEQ;
    const int tt = tid >> 4, jg = tid & 15, j4 = 4 * jg, ch = h * 64 + j4;
    __syncthreads();
    for (int e = tid; e < 2048; e += 512) { const int m = e >> 6, j = e & 63;
        ((LAS unsigned short*)(lds + O_WUP))[j * 40 + m] = (unsigned short)(pk2(sp.w_up[m * 512 + h * 64 + j], 0.f) & 0xffffu);
        ((LAS unsigned short*)(lds + O_WUP + 5120))[j * 40 + m] = (unsigned short)(pk2(sp.a_up[m * 512 + h * 64 + j], 0.f) & 0xffffu); }
    LAS float* par = (LAS float*)(lds + 98048);
    if (tid < 64) {
        const int c_ = h * 64 + tid;
        par[0 * 64 + tid] = sp.mu[c_]; par[1 * 64 + tid] = sp.mu[512 + c_]; par[2 * 64 + tid] = sp.mu[1024 + c_]; par[3 * 64 + tid] = sp.mu[1536 + tid];
        par[4 * 64 + tid] = sp.w0[c_]; par[5 * 64 + tid] = sp.a0[c_]; par[6 * 64 + tid] = sp.kkr[c_]; par[7 * 64 + tid] = sp.kkr[512 + c_]; par[8 * 64 + tid] = sp.kkr[1024 + c_];
        par[9 * 64 + tid] = sp.ln_gain[c_] * sp.out_gain[1536 + c_]; par[10 * 64 + tid] = sp.ln_bias[c_];
    }
#define PARV(k) (*(const LAS f32x4*)(par + (k) * 64 + j4))
    __syncthreads();
    f32x16 Hacc[2];
    {
        const int ln0 = lane & 31, hh0 = lane >> 5, cb0 = w & 1;
#pragma unroll
        for (int jb = 0; jb < 2; ++jb)
#pragma unroll
            for (int i = 0; i < 16; ++i) Hacc[jb][i] = (w >= 2 && w < 4 && (32 * jb + crow(i, hh0)) == (32 * cb0 + ln0)) ? 1.f : 0.f;
    }
    f32x4 n_cur, n_prv; u32x2 n_rc, n_kc, n_vc, n_rq, n_kq, n_vq;
#define SCAN_PREFETCH(tk, hasprev) do { const size_t tk_ = (tk); n_cur = *(const f32x4*)(sp.misc + tk_ * MISCP + j4); const bf16_t* rp_ = sp.P + tk_ * PP + 2048 + ch; \
        n_rc = *(const u32x2*)rp_; n_kc = *(const u32x2*)(rp_ + 512); n_vc = *(const u32x2*)(rp_ + 1024); \
        if (hasprev) { n_prv = *(const f32x4*)(sp.misc + (tk_ - 1) * MISCP + j4); n_rq = *(const u32x2*)(rp_ - PP); n_kq = *(const u32x2*)(rp_ - PP + 512); n_vq = *(const u32x2*)(rp_ - PP + 1024); } \
        else { n_prv = (f32x4){0.f, 0.f, 0.f, 0.f}; n_rq = (u32x2){0u, 0u}; n_kq = n_rq; n_vq = n_rq; } } while (0)
    SCAN_PREFETCH((size_t)(tok0 + seg * 1024 + tt), (seg * 1024 + tt) > 0);
    f32x4 r4, k4, v4, lw, kkn, kp, bb; float bon = 0.f;
    for (int ci = -1; ci < 32; ++ci) {
        f32x16 P1, P2;
        int lnv_ = lane; asm volatile("" : "+v"(lnv_)); const int ln = lnv_ & 31, hh = lnv_ >> 5;
        const float bon_c = bon; const int tokc_i = tok0 + seg * 1024 + ci * 32 + tt;
        if (ci >= 0) {
        __syncthreads();
        {
            const f32x4 r4 = *(const LAS f32x4*)(stash + tid * 12), v4 = *(const LAS f32x4*)(stash + tid * 12 + 4), kp = *(const LAS f32x4*)(stash + tid * 12 + 8);
            f32x4 cl = {0.f, 0.f, 0.f, 0.f};
#pragma unroll 2
            for (int s4 = 0; s4 < w; ++s4) {
                const LAS float* lp_ = lwS + (4 * s4) * 64 + j4;
                const f32x4 x0 = *(const LAS f32x4*)lp_, x1 = *(const LAS f32x4*)(lp_ + 64), x2 = *(const LAS f32x4*)(lp_ + 128), x3 = *(const LAS f32x4*)(lp_ + 192);
                cl += (x0 + x1) + (x2 + x3);
            }
#pragma unroll
            for (int q = 0; q < 4; ++q) { const int s = 4 * w + q; const f32x4 x = *(const LAS f32x4*)(lwS + s * 64 + j4); if (s <= tt) cl += x; }
            f32x4 ein, eex, einv;
#pragma unroll
            for (int e = 0; e < 4; ++e) { ein[e] = ex2(cl[e]); eex[e] = ex2(cl[e] - lw[e]); einv[e] = __builtin_amdgcn_rcpf(ein[e]); }
            const f32x4 kkt = kkn * eex, rt = r4 * ein, kh = kp * einv, bh = bb * einv;
            u32x2 o;
            o.x = pk2(kkt[0], kkt[1]); o.y = pk2(kkt[2], kkt[3]); *(LAS u32x2*)(lds + O_KK + (tt * 72 + j4) * 2) = o;
            o.x = pk2(rt[0], rt[1]); o.y = pk2(rt[2], rt[3]); *(LAS u32x2*)(lds + O_R + (tt * 72 + j4) * 2) = o;
            o.x = pk2(kh[0], kh[1]); o.y = pk2(kh[2], kh[3]); *(LAS u32x2*)(lds + O_K + (tt * 72 + j4) * 2) = o;
            const unsigned k01 = o.x, k23 = o.y;
            o.x = pk2(bh[0], bh[1]); o.y = pk2(bh[2], bh[3]); *(LAS u32x2*)(lds + O_B + (tt * 72 + j4) * 2) = o;
            const unsigned nb01 = pk2(-bh[0], -bh[1]), nb23 = pk2(-bh[2], -bh[3]);
            const unsigned v01 = pk2(v4[0], v4[1]), v23 = pk2(v4[2], v4[3]);
            LAS unsigned short* kt = (LAS unsigned short*)(lds + O_KT) + j4 * 40 + tt;
            kt[0] = (unsigned short)(k01 & 0xffffu); kt[40] = (unsigned short)(k01 >> 16); kt[80] = (unsigned short)(k23 & 0xffffu); kt[120] = (unsigned short)(k23 >> 16);
            LAS unsigned short* bt = (LAS unsigned short*)(lds + O_BT) + j4 * 40 + tt;
            bt[0] = (unsigned short)(nb01 & 0xffffu); bt[40] = (unsigned short)(nb01 >> 16); bt[80] = (unsigned short)(nb23 & 0xffffu); bt[120] = (unsigned short)(nb23 >> 16);
            LAS unsigned short* vt = (LAS unsigned short*)(lds + O_VT) + j4 * 40 + tt;
            vt[0] = (unsigned short)(v01 & 0xffffu); vt[40] = (unsigned short)(v01 >> 16); vt[80] = (unsigned short)(v23 & 0xffffu); vt[120] = (unsigned short)(v23 >> 16);
            if (tt == 31) *(LAS f32x4*)(gam + j4) = ein;
        }
        __syncthreads();
        if (w < 4) {
#pragma unroll
            for (int i = 0; i < 16; ++i) { P1[i] = 0.f; P2[i] = 0.f; }
#pragma unroll
            for (int jb = 0; jb < 2; ++jb)
#pragma unroll
                for (int s = 0; s < 2; ++s) {
                    const bf16x8 hb = pack8(Hacc[jb], s);
                    const int off = (ln * 72 + 32 * jb + 16 * s + 4 * hh) * 2;
                    P1 = MFMA32(ld_krow(lds + O_KK + off), hb, P1);
                    P2 = MFMA32(ld_krow(lds + O_R + off), hb, P2);
                }
        } else {
            const int job = w - 4;
            const int oa = (job == 0 || job == 2) ? O_K : O_B, ob = (job < 2) ? O_KK : O_R;
            f32x16 Z;
#pragma unroll
            for (int i = 0; i < 16; ++i) Z[i] = 0.f;
#pragma unroll
            for (int ks = 0; ks < 4; ++ks) {
                const int off = (ln * 72 + ks * 16 + hh * 8) * 2;
                Z = MFMA32(*(const LAS bf16x8*)(lds + oa + off), *(const LAS bf16x8*)(lds + ob + off), Z);
            }
            if (job == 1) {
#pragma unroll
                for (int r = 0; r < 16; ++r) { const int c = crow(r, hh); NT[c * 32 + ln] = (c < ln) ? Z[r] : 0.f; }
                {
                    const bool lowrow = ln < 16;
                    u32x2 a_, b_;
                    a_.x = lowrow ? 0u : pk2(-Z[0], -Z[1]); a_.y = lowrow ? 0u : pk2(-Z[2], -Z[3]);
                    b_.x = lowrow ? 0u : pk2(-Z[4], -Z[5]); b_.y = lowrow ? 0u : pk2(-Z[6], -Z[7]);
                    *(LAS u32x2*)(lds + O_N21 + (ln * 40 + 4 * hh) * 2) = a_;
                    *(LAS u32x2*)(lds + O_N21 + (ln * 40 + 8 + 4 * hh) * 2) = b_;
                }
                asm volatile("s_waitcnt lgkmcnt(0)" ::: "memory");
                float Tr[16];
                const int tb = ln >> 4, tl = ln & 15;
                const LAS float* NTl = NT + tb * (16 * 32 + 16); asm volatile("" : "+v"(NTl));
                f32x4 nvc[4], nvn[4];
#pragma unroll
                for (int m = 0; m < 4; ++m) { nvc[m] = (f32x4){0.f, 0.f, 0.f, 0.f}; nvn[m] = nvc[m]; }
#pragma unroll
                for (int cc = 0; cc < 16; ++cc) {
                    const int cl = 15 - cc;
                    if (cl >= 1) {
#pragma unroll
                        for (int m = 0; m < 4; ++m) if (4 * m + 3 > cl - 1) nvn[m] = *(const LAS f32x4*)(NTl + (cl - 1) * 32 + 4 * m);
                    }
                    float s0 = (cl == tl) ? 1.f : 0.f, s1 = 0.f, s2 = 0.f, s3 = 0.f;
#pragma unroll
                    for (int m = 0; m < 4; ++m) {
                        if (4 * m + 3 > cl) {
                            if (4 * m + 0 > cl) s0 -= Tr[4 * m + 0] * nvc[m][0];
                            if (4 * m + 1 > cl) s1 -= Tr[4 * m + 1] * nvc[m][1];
                            if (4 * m + 2 > cl) s2 -= Tr[4 * m + 2] * nvc[m][2];
                            if (4 * m + 3 > cl) s3 -= Tr[4 * m + 3] * nvc[m][3];
                        }
                    }
                    Tr[cl] = (s0 + s1) + (s2 + s3);
                    asm volatile("" : "+v"(Tr[cl]) :: "memory");
#pragma unroll
                    for (int m = 0; m < 4; ++m) nvc[m] = nvn[m];
                }
                if (hh == 0) {
#pragma unroll
                    for (int q = 0; q < 4; ++q) {
                        const bool mine = (q >> 1) == tb; const int o8 = 8 * (q & 1);
                        u32x4 o; o.x = mine ? pk2(Tr[o8], Tr[o8 + 1]) : 0u; o.y = mine ? pk2(Tr[o8 + 2], Tr[o8 + 3]) : 0u; o.z = mine ? pk2(Tr[o8 + 4], Tr[o8 + 5]) : 0u; o.w = mine ? pk2(Tr[o8 + 6], Tr[o8 + 7]) : 0u;
                        *(LAS u32x4*)(lds + O_TM + ln * 80 + 16 * q) = o;
                    }
                }
            } else {
                const int oo = (job == 0) ? O_MK : (job == 2) ? O_NK : O_NB;
#pragma unroll
                for (int g = 0; g < 4; ++g) {
                    float z[4];
#pragma unroll
                    for (int e = 0; e < 4; ++e) {
                        const int s = 8 * g + 4 * hh + e;
                        const bool keep = (job == 0) ? (s < ln) : (s <= ln);
                        float v = keep ? Z[4 * g + e] : 0.f; if (job == 3) v = -v; z[e] = v;
                    }
                    u32x2 o; o.x = pk2(z[0], z[1]); o.y = pk2(z[2], z[3]);
                    *(LAS u32x2*)(lds + oo + (ln * 40 + 8 * g + 4 * hh) * 2) = o;
                }
            }
        }
        }
        if (ci + 1 < 32) {
        const int chunk = ci + 1;
        const int t0 = seg * 1024 + chunk * 32, t = t0 + tt; const size_t tok = (size_t)(tok0 + t);
        {
            const f32x4 cur = n_cur, prv = n_prv;
            f32x4 s = cur + (prv - cur) * PARV(3);
            if (jg < 8) {
#pragma unroll
                for (int e = 0; e < 4; ++e) s[e] = 1.0f - 2.0f * __builtin_amdgcn_rcpf(1.0f + __expf(2.0f * s[e]));
            }
            { u32x2 o_; o_.x = pk2(s[0], s[1]); o_.y = pk2(s[2], s[3]); *(LAS u32x2*)(lds + O_LORA + (tt * 72 + j4) * 2) = o_; }
        }
        {
            const u32x2 rc = n_rc, kc = n_kc, vc = n_vc, rq = n_rq, kq = n_kq, vq = n_vq;
            const f32x4 rcf = {bflo(rc.x), bfhi(rc.x), bflo(rc.y), bfhi(rc.y)}, rqf = {bflo(rq.x), bfhi(rq.x), bflo(rq.y), bfhi(rq.y)};
            const f32x4 kcf = {bflo(kc.x), bfhi(kc.x), bflo(kc.y), bfhi(kc.y)}, kqf = {bflo(kq.x), bfhi(kq.x), bflo(kq.y), bfhi(kq.y)};
            const f32x4 vcf = {bflo(vc.x), bfhi(vc.x), bflo(vc.y), bfhi(vc.y)}, vqf = {bflo(vq.x), bfhi(vq.x), bflo(vq.y), bfhi(vq.y)};
            r4 = rcf + (rqf - rcf) * PARV(0); k4 = kcf + (kqf - kcf) * PARV(1); v4 = vcf + (vqf - vcf) * PARV(2);
        }
        if (chunk + 1 < 32) SCAN_PREFETCH(tok + 32, 1);
        asm volatile("s_waitcnt lgkmcnt(0)" ::: "memory");
        bon = 0.f;
        {
            f32x4 wacc, aacc;
            {
                const int l5_ = lane & 31, h5_ = lane >> 5;
                const LAS unsigned char* arow = lds + O_LORA + ((4 * w + (l5_ & 3)) * 72 + h5_ * 8) * 2;
#pragma unroll
                for (int lo_ = 0; lo_ < 2; ++lo_)
#pragma unroll
                    for (int jb_ = 0; jb_ < 2; ++jb_) {
                        f32x16 D_;
#pragma unroll
                        for (int i = 0; i < 16; ++i) D_[i] = 0.f;
#pragma unroll
                        for (int ks = 0; ks < 2; ++ks)
                            D_ = MFMA32(*(const LAS bf16x8*)(arow + (lo_ * 32 + ks * 16) * 2), *(const LAS bf16x8*)(lds + O_WUP + lo_ * 5120 + ((32 * jb_ + l5_) * 40 + ks * 16 + h5_ * 8) * 2), D_);
                        if (h5_ == 0) {
                            LAS float* dst_ = (lo_ == 0 ? yb : qb) + (w * 4) * 64 + 32 * jb_ + l5_;
                            dst_[0] = D_[0]; dst_[64] = D_[1]; dst_[128] = D_[2]; dst_[192] = D_[3];
                        }
                    }
                asm volatile("s_waitcnt lgkmcnt(0)" ::: "memory");
                wacc = PARV(4) + *(const LAS f32x4*)(yb + (w * 4 + (lane >> 4)) * 64 + j4);
                aacc = PARV(5) + *(const LAS f32x4*)(qb + (w * 4 + (lane >> 4)) * 64 + j4);
            }
            float ssq = 0.f; f32x4 av;
#pragma unroll
            for (int e = 0; e < 4; ++e) {
                const float xw = -wacc[e]; const float spv = fmaxf(xw, 0.f) + __logf(1.0f + __expf(-fabsf(xw)));
                lw[e] = -__expf(-spv - 0.5f) * LOG2E;
                av[e] = __builtin_amdgcn_rcpf(1.0f + __expf(-aacc[e]));
                kkn[e] = k4[e] * PARV(6)[e]; ssq += kkn[e] * kkn[e];
            }
            ssq = red16(ssq);
            const float inrm = __builtin_amdgcn_rsqf(fmaxf(ssq, 1e-24f));
#pragma unroll
            for (int e = 0; e < 4; ++e) {
                kkn[e] *= inrm; kp[e] = k4[e] * (1.0f + (av[e] - 1.0f) * PARV(7)[e]); bb[e] = kkn[e] * av[e];
                bon += r4[e] * kp[e] * PARV(8)[e];
            }
            bon = red16(bon);
            *(LAS f32x4*)(lwS + tt * 64 + j4) = lw;
            *(LAS f32x4*)(stash + tid * 12) = r4; *(LAS f32x4*)(stash + tid * 12 + 4) = v4; *(LAS f32x4*)(stash + tid * 12 + 8) = kp;
        }
        }
        if (ci >= 0) {
        __syncthreads();
        if (w < 4) {
            const bool isH = w < 2;
            const int icol = 32 * (w & 1) + ln;
            bf16x8 vfr[2];
            if (isH) {
#pragma unroll
                for (int ks = 0; ks < 2; ++ks) vfr[ks] = *(const LAS bf16x8*)(lds + O_VT + (icol * 40 + ks * 16 + hh * 8) * 2);
#pragma unroll
                for (int ks = 0; ks < 2; ++ks) {
                    P1 = MFMA32(*(const LAS bf16x8*)(lds + O_MK + (ln * 40 + ks * 16 + hh * 8) * 2), vfr[ks], P1);
                    P2 = MFMA32(*(const LAS bf16x8*)(lds + O_NK + (ln * 40 + ks * 16 + hh * 8) * 2), vfr[ks], P2);
                }
            }
            f32x16 Aa;
#pragma unroll
            for (int i = 0; i < 16; ++i) Aa[i] = 0.f;
#pragma unroll
            for (int s = 0; s < 1; ++s) Aa = MFMA32(ld_krow(lds + O_TM + (ln * 40 + 4 * hh) * 2), pack8(P1, 0), Aa);
            P1 = MFMA32(ld_krow(lds + O_N21 + (ln * 40 + 4 * hh) * 2), pack8(Aa, 0), P1);
            Aa = MFMA32(ld_krow(lds + O_TM + (ln * 40 + 16 + 4 * hh) * 2), pack8(P1, 1), Aa);
            bf16x8 ab[2]; ab[0] = pack8(Aa, 0); ab[1] = pack8(Aa, 1);
#pragma unroll
            for (int s = 0; s < 2; ++s) P2 = MFMA32(ld_krow(lds + O_NB + (ln * 40 + 16 * s + 4 * hh) * 2), ab[s], P2);
#pragma unroll
            for (int jb = 0; jb < 2; ++jb) {
                if (isH) {
#pragma unroll
                    for (int ks = 0; ks < 2; ++ks) Hacc[jb] = MFMA32(*(const LAS bf16x8*)(lds + O_KT + ((32 * jb + ln) * 40 + ks * 16 + hh * 8) * 2), vfr[ks], Hacc[jb]);
                }
#pragma unroll
                for (int s = 0; s < 2; ++s) Hacc[jb] = MFMA32(ld_krow(lds + O_BT + ((32 * jb + ln) * 40 + 16 * s + 4 * hh) * 2), ab[s], Hacc[jb]);
#pragma unroll
                for (int g = 0; g < 4; ++g) {
                    const f32x4 gv = *(const LAS f32x4*)(gam + 32 * jb + 8 * g + 4 * hh);
                    Hacc[jb][4 * g] *= gv[0]; Hacc[jb][4 * g + 1] *= gv[1]; Hacc[jb][4 * g + 2] *= gv[2]; Hacc[jb][4 * g + 3] *= gv[3];
                }
            }
            LAS float* ob = isH ? yb : qb;
#pragma unroll
            for (int r = 0; r < 16; ++r) ob[crow(r, hh) * 64 + icol] = P2[r];
        }
        __syncthreads();
        {
            const f32x4 y = *(const LAS f32x4*)(yb + tt * 64 + j4);
            const f32x4 q = *(const LAS f32x4*)(qb + tt * 64 + j4);
            u32x2 o; o.x = pk2(y[0], y[1]); o.y = pk2(y[2], y[3]);
            *(u32x2*)(sp.mixed + (size_t)tokc_i * 1024 + 512 + ch) = o;
            o.x = pk2(q[0], q[1]); o.y = pk2(q[2], q[3]);
            *(u32x2*)(sp.Q + (size_t)tokc_i * 512 + ch) = o;
            if (jg == 0) sp.bon[(size_t)tokc_i * 8 + h] = bon_c;
        }
        }
    }
    if (w < 4) {
        int le_ = lane; asm volatile("" : "+v"(le_));
        const int ln = le_ & 31, hh = le_ >> 5, icol = 32 * (w & 1) + ln;
        float* dst = ((w < 2) ? sp.HE : sp.PE) + (size_t)((b * 8 + h) * 4 + seg) * 4096;
#pragma unroll
        for (int jb = 0; jb < 2; ++jb)
#pragma unroll
            for (int r = 0; r < 16; ++r) dst[(32 * jb + crow(r, hh)) * 64 + icol] = Hacc[jb][r];
    }
#undef SCAN_PREFETCH
#undef PARV
}

__device__ __forceinline__ void scan_pass2(const ScanP& sp, int b, int h, int seg, LAS unsigned char* lds) {
    int tid_ = threadIdx.x; asm volatile("" : "+v"(tid_));
    const int tid = tid_, lane = tid & 63, w = __builtin_amdgcn_readfirstlane(tid >> 6);
    LAS float* Hc = (LAS float*)lds; LAS float* Hn = Hc + 4096;
    LAS unsigned char* HiT = lds + 32768;
    LAS float* par = (LAS float*)(lds + 32768 + 9216);
    LAS float* ybw = (LAS float*)(lds + 43008) + w * 2048;
    const int tok0 = b * SEQ;
    __syncthreads();
    if (tid < 64) { const int c_ = h * 64 + tid; par[tid] = sp.mu[1024 + c_]; par[64 + tid] = sp.ln_gain[c_] * sp.out_gain[1536 + c_]; par[128 + tid] = sp.ln_bias[c_]; }
    const int j = tid >> 3, i8 = (tid & 7) * 8;
    *(LAS f32x4*)(Hc + j * 64 + i8) = (f32x4){0.f, 0.f, 0.f, 0.f}; *(LAS f32x4*)(Hc + j * 64 + i8 + 4) = (f32x4){0.f, 0.f, 0.f, 0.f};
    __syncthreads();
    for (int s = 0; s < seg; ++s) {
        const float* HE = sp.HE + (size_t)((b * 8 + h) * 4 + s) * 4096; const float* PE = sp.PE + (size_t)((b * 8 + h) * 4 + s) * 4096;
        f32x4 a0 = *(const f32x4*)(HE + j * 64 + i8), a1 = *(const f32x4*)(HE + j * 64 + i8 + 4);
        f32x4 pvr[16];
#pragma unroll
        for (int jq = 0; jq < 16; ++jq) pvr[jq] = *(const f32x4*)(PE + j * 64 + 4 * jq);
#pragma unroll
        for (int jq = 0; jq < 16; ++jq) {
#pragma unroll
            for (int q = 0; q < 4; ++q) {
                const f32x4 h0 = *(const LAS f32x4*)(Hc + (4 * jq + q) * 64 + i8), h1 = *(const LAS f32x4*)(Hc + (4 * jq + q) * 64 + i8 + 4);
                a0 += h0 * pvr[jq][q]; a1 += h1 * pvr[jq][q];
            }
        }
        *(LAS f32x4*)(Hn + j * 64 + i8) = a0; *(LAS f32x4*)(Hn + j * 64 + i8 + 4) = a1;
        __syncthreads();
        LAS float* t_ = Hc; Hc = Hn; Hn = t_;
    }
    {
        const f32x4 h0 = *(const LAS f32x4*)(Hc + j * 64 + i8), h1 = *(const LAS f32x4*)(Hc + j * 64 + i8 + 4);
        const unsigned p0 = pk2(h0[0], h0[1]), p1 = pk2(h0[2], h0[3]), p2 = pk2(h1[0], h1[1]), p3 = pk2(h1[2], h1[3]);
        LAS unsigned short* d = (LAS unsigned short*)HiT + i8 * 72 + j;
        d[0] = (unsigned short)(p0 & 0xffffu); d[72] = (unsigned short)(p0 >> 16); d[144] = (unsigned short)(p1 & 0xffffu); d[216] = (unsigned short)(p1 >> 16);
        d[288] = (unsigned short)(p2 & 0xffffu); d[360] = (unsigned short)(p2 >> 16); d[432] = (unsigned short)(p3 & 0xffffu); d[504] = (unsigned short)(p3 >> 16);
    }
    __syncthreads();
    const int ln = lane & 31, hh = lane >> 5;
    for (int c = w; c < 32; c += 8) {
        const int t0 = seg * 1024 + c * 32;
#pragma unroll
        for (int ib = 0; ib < 2; ++ib) {
            f32x16 acc;
#pragma unroll
            for (int i = 0; i < 16; ++i) acc[i] = 0.f;
#pragma unroll
            for (int ks = 0; ks < 4; ++ks) {
                const bf16x8 qa = *(const bf16x8*)(sp.Q + (size_t)(tok0 + t0 + ln) * 512 + h * 64 + ks * 16 + hh * 8);
                const bf16x8 hb = *(const LAS bf16x8*)(HiT + ((ib * 32 + ln) * 72 + ks * 16 + hh * 8) * 2);
                acc = MFMA32(qa, hb, acc);
            }
#pragma unroll
            for (int r = 0; r < 16; ++r) ybw[crow(r, hh) * 64 + ib * 32 + ln] = acc[r];
        }
        asm volatile("s_waitcnt lgkmcnt(0)" ::: "memory");
#pragma unroll 4
        for (int it = 0; it < 8; ++it) {
            const int item = it * 64 + lane, tt = item >> 4, jg = item & 15, j4 = 4 * jg, ch = h * 64 + j4;
            const int t = t0 + tt; const size_t tok = (size_t)(tok0 + t);
            const u32x2 y0 = *(const u32x2*)(sp.mixed + tok * 1024 + 512 + ch);
            const f32x4 dy = *(const LAS f32x4*)(ybw + tt * 64 + j4);
            const f32x4 y = {bflo(y0.x) + dy[0], bfhi(y0.x) + dy[1], bflo(y0.y) + dy[2], bfhi(y0.y) + dy[3]};
            const float mean = red16((y[0] + y[1]) + (y[2] + y[3])) * (1.0f / 64.0f);
            const f32x4 dlt = y - mean;
            const float var = red16((dlt[0] * dlt[0] + dlt[1] * dlt[1]) + (dlt[2] * dlt[2] + dlt[3] * dlt[3])) * (1.0f / 64.0f);
            const float rs = __builtin_amdgcn_rsqf(var + 64e-5f);
            const bf16_t* vp = sp.P + tok * PP + 3072 + ch;
            const u32x2 vc = *(const u32x2*)vp; u32x2 vq = {0u, 0u}; if (t > 0) vq = *(const u32x2*)(vp - PP);
            const f32x4 vcf = {bflo(vc.x), bfhi(vc.x), bflo(vc.y), bfhi(vc.y)}, vqf = {bflo(vq.x), bfhi(vq.x), bflo(vq.y), bfhi(vq.y)};
            const f32x4 v4 = vcf + (vqf - vcf) * *(const LAS f32x4*)(par + j4);
            const float bon = sp.bon[tok * 8 + h];
            const u32x2 gr = *(const u32x2*)(sp.P + tok * PP + 3584 + ch);
            const f32x4 yo = dlt * rs * *(const LAS f32x4*)(par + 64 + j4) + *(const LAS f32x4*)(par + 128 + j4) + v4 * bon;
            u32x2 o; o.x = pk2(yo[0] * silu(bflo(gr.x)), yo[1] * silu(bfhi(gr.x))); o.y = pk2(yo[2] * silu(bflo(gr.y)), yo[3] * silu(bfhi(gr.y)));
            *(u32x2*)(sp.mixed + tok * 1024 + 512 + ch) = o;
        }
        asm volatile("s_waitcnt lgkmcnt(0)" ::: "memory");
    }
}

__device__ __forceinline__ int next_item(unsigned* ctr, LAS unsigned* slot) {
    __syncthreads();
    if (threadIdx.x == 0) *slot = atomicAdd(ctr, 1u);
    __syncthreads();
    return (int)*slot;
}

__device__ __forceinline__ void xbar(unsigned* ctl, unsigned k, unsigned x, unsigned nloc, unsigned nx) {
    asm volatile("s_waitcnt vmcnt(0)" ::: "memory");
    __syncthreads();
    if (threadIdx.x == 0) {
        const unsigned old = __hip_atomic_fetch_add(ctl + 2048 + 64 * x, 1u, __ATOMIC_RELAXED, __HIP_MEMORY_SCOPE_AGENT);
        if (old + 1u == nloc * (k + 1u)) {
            __builtin_amdgcn_fence(__ATOMIC_RELEASE, "agent");
            __hip_atomic_fetch_add(ctl + 3072, 1u, __ATOMIC_RELAXED, __HIP_MEMORY_SCOPE_AGENT);
        }
        const unsigned target = nx * (k + 1u);
        while (__hip_atomic_load(ctl + 3072, __ATOMIC_RELAXED, __HIP_MEMORY_SCOPE_AGENT) < target) __builtin_amdgcn_s_sleep(1);
    }
    __syncthreads();
    __builtin_amdgcn_fence(__ATOMIC_ACQUIRE, "agent");
    asm volatile("s_waitcnt vmcnt(0)" ::: "memory");
}

__global__ void __launch_bounds__(512) hymba_fwd(Args a) {
    extern __shared__ __attribute__((aligned(16))) unsigned char lds_raw[];
    LAS unsigned char* lds = (LAS unsigned char*)lds_raw;
    LAS unsigned* qslot = (LAS unsigned*)(lds + QSLOT_OFF);
#define WSPTRS unsigned char* ws_ = a.ws; asm volatile("" : "+s"(ws_)); unsigned* ctl = (unsigned*)(ws_ + WS_CTL); bf16_t* WtIn = (bf16_t*)(ws_ + WS_WIN); bf16_t* WtOut = (bf16_t*)(ws_ + WS_WOUT); \
    bf16_t* hb = (bf16_t*)(ws_ + WS_HB); bf16_t* proj = (bf16_t*)(ws_ + WS_PROJ); float* misc = (float*)(ws_ + WS_MISC); \
    bf16_t* mixed = (bf16_t*)(ws_ + WS_MIXED); float* hss = (float*)(ws_ + WS_HSS); const float* biasT = (const float*)(ws_ + WS_BIAS); float* outp = a.out; asm volatile("" : "+s"(outp)); \
    (void)ctl; (void)WtIn; (void)WtOut; (void)hb; (void)proj; (void)misc; (void)mixed; (void)hss; (void)biasT; (void)outp;
    const int lo = a.ph_lo, hi = a.ph_hi;
#define IN(k) (lo <= (k) && (k) < hi)
    unsigned nloc = 1, nxcd = 1;
    const unsigned xcc = (unsigned)__builtin_amdgcn_s_getreg((3 << 11) | 20) & 0xFu;
    if (threadIdx.x == 0) __hip_atomic_fetch_add((unsigned*)(a.ws + WS_CTL) + 1024 + 64 * xcc, 1u, __ATOMIC_RELAXED, __HIP_MEMORY_SCOPE_AGENT);
#define SEAM(k, bi) do { if (IN(k) && IN((k) + 1)) { if ((k) == 0) { cg::this_grid().sync(); \
            { unsigned* c_ = (unsigned*)(a.ws + WS_CTL) + 1024; nloc = (unsigned)__builtin_amdgcn_readfirstlane((int)__hip_atomic_load(c_ + 64 * xcc, __ATOMIC_RELAXED, __HIP_MEMORY_SCOPE_AGENT)); unsigned nx_ = 0; \
                for (int q_ = 0; q_ < 16; ++q_) nx_ += (__hip_atomic_load(c_ + 64 * q_, __ATOMIC_RELAXED, __HIP_MEMORY_SCOPE_AGENT) != 0u) ? 1u : 0u; nxcd = (unsigned)__builtin_amdgcn_readfirstlane((int)nx_); } } \
        else xbar((unsigned*)(a.ws + WS_CTL), (unsigned)(bi), xcc, nloc, nxcd); } } while (0)
    if (IN(0)) { prologue(a, lds); }
    SEAM(0, 0);
#pragma unroll 1
    for (int l = 0; l < 2; ++l) {
        const int pb = 1 + 5 * l;
        if (IN(pb)) for (int rep = 0; rep < REP1A; ++rep) {
            WSPTRS
            if (rep) cg::this_grid().sync();
            pg8::Gemm g{hb, WtIn + (size_t)l * NINP * 1024, NTOK, NCD, 1024}; pg8::StaticOrder S; S.init(NTOK, NCD, gridDim.x, (int)blockIdx.x);
            pg8::EpiIn E{proj, misc, hss, 16};
            pg8::gemm_phase<pg8::EpiIn, pg8::StaticOrder, true, true>(lds, g, S, E);
        }
        SEAM(pb, 6 * l + 0);
        if (IN(pb + 1)) {
            WSPTRS
            ScanP sp{proj, mixed, misc, a.rwkv_mu + l * 1600, a.rwkv_w_up + l * 32 * 512, a.rwkv_w0 + l * 512, a.rwkv_a_up + l * 32 * 512, a.rwkv_a0 + l * 512,
                     a.rwkv_kkr + l * 3 * 512, a.rwkv_ln_gain + l * 512, a.rwkv_ln_bias + l * 512, a.out_gain + l * 2048,
                     (bf16_t*)(ws_ + WS_Q), (float*)(ws_ + WS_BON), (float*)(ws_ + WS_HE), (float*)(ws_ + WS_PE)};
            AttnP ap{proj, mixed, misc, a.qk_gain + l * 256, a.out_gain + l * 2048, biasT, a.forget_bias + l * 8, 0.f, 0.f};
            for (;;) {
                const int idx = next_item(ctl + pb + 1, qslot);
                if (idx >= 256 + 1024) break;
                if (idx < 256) {
#ifndef DIS_S
                    scan_pass1(sp, idx >> 5, (idx >> 2) & 7, idx & 3, lds);
#endif
                } else {
                    const int ci = idx - 256, qb = 15 - (ci >> 6), bh = ci & 63;
#ifndef DIS_C
                    attn_item<2>(ap, bh >> 3, bh & 7, qb, lds);
#endif
                }
            }
            xbar(ctl, (unsigned)(6 * l + 1), xcc, nloc, nxcd);
            for (;;) {
                const int idx = next_item(ctl + 32 + pb + 1, qslot);
                if (idx >= 256) break;
                if (idx < 256) {
#ifndef DIS_S
                    scan_pass2(sp, idx >> 5, (idx >> 2) & 7, idx & 3, lds);
#endif
                } else {
                    const int ci = 768 + idx - 256, qb = 15 - (ci >> 6), bh = ci & 63;
#ifndef DIS_C
                    attn_item<2>(ap, bh >> 3, bh & 7, qb, lds);
#endif
                }
            }
        }
        SEAM(pb + 1, 6 * l + 2);
        if (IN(pb + 2)) {
            WSPTRS
            {
                pg8::Gemm g{hb, WtIn + (size_t)l * NINP * 1024 + (size_t)NCD * 1024, NTOK, 4096, 1024}; pg8::StaticOrder S; S.init(NTOK, 4096, gridDim.x, (int)blockIdx.x);
                pg8::EpiIn E{proj, misc, hss, 16};
                pg8::gemm_phase<pg8::EpiIn, pg8::StaticOrder, true, true>(lds, g, S, E);
            }
            {
                pg8::Gemm g{mixed, WtOut + (size_t)(2 * l) * 1024 * 1024, NTOK, 1024, 1024}; pg8::StaticOrder S; S.init(NTOK, 1024, gridDim.x, (int)blockIdx.x);
                pg8::EpiOut E{l == 0 ? a.x : outp, outp, hb, hss, 0};
                pg8::gemm_phase<pg8::EpiOut, pg8::StaticOrder, true, true>(lds, g, S, E);
            }
        }
        SEAM(pb + 2, 6 * l + 3);
        if (IN(pb + 3)) for (int rep = 0; rep < REP2B; ++rep) {
            WSPTRS
            if (rep) cg::this_grid().sync();
            float lam;
            {
                const float* dl = a.diff_lambda + l * 256; int tl_ = threadIdx.x; asm volatile("" : "+v"(tl_)); const int lane = tl_ & 63;
                const float s1 = wave_sum(dl[lane] * dl[64 + lane]), s2 = wave_sum(dl[128 + lane] * dl[192 + lane]);
                const float lam_init = 0.8f - 0.6f * expf(-0.3f * (float)l);
                lam = expf(s1) - expf(s2) + lam_init;
                const float lam_u = __int_as_float(__builtin_amdgcn_readfirstlane(__float_as_int(lam))), oml_u = __int_as_float(__builtin_amdgcn_readfirstlane(__float_as_int(1.0f - lam_init)));
                AttnP ap{proj, mixed, misc, a.qk_gain + l * 256, a.out_gain + l * 2048, biasT, a.forget_bias + l * 8, lam_u, oml_u};
                for (;;) {
                    const int idx = next_item(ctl + pb + 3 + 16 * rep, qslot);
                    if (idx >= 1536) break;
                    if (idx < 512) { const int qb = 15 - (idx >> 5), bh = idx & 31;
#ifndef DIS_A
 attn_item<0>(ap, bh >> 2, bh & 3, qb, lds);
#endif
 }
                    else { const int i2 = idx - 512, qb = 15 - (i2 >> 6), bh = i2 & 63;
#ifndef DIS_B
 attn_item<1>(ap, bh >> 3, bh & 7, qb, lds);
#endif
 }
                }
            }
        }
        SEAM(pb + 3, 6 * l + 4);
        if (IN(pb + 4)) {
            WSPTRS
            pg8::Gemm g{mixed, WtOut + (size_t)(2 * l + 1) * 1024 * 1024, NTOK, 1024, 1024}; pg8::StaticOrder S; S.init(NTOK, 1024, gridDim.x, (int)blockIdx.x);
            pg8::EpiOut E{outp, outp, hb, hss, l == 0 ? 1 : 0};
            pg8::gemm_phase<pg8::EpiOut, pg8::StaticOrder, true, true>(lds, g, S, E);
        }
        if (l == 0) SEAM(pb + 4, 6 * l + 5);
    }
#undef IN
#undef SEAM
}

extern "C" void kernel_launch(void* const* d_in, const int* in_sizes, int n_in, void* d_out, int out_size, void* d_ws, size_t ws_size, hipStream_t stream) {
    static int grid = 0;
    if (grid == 0) {
        if (n_in != 17 || ws_size < WS_END) { fprintf(stderr, "kernel_launch: unexpected inputs (n_in %d, ws %zu < %zu)\n", n_in, ws_size, (size_t)WS_END); grid = -1; return; }
        int dev = 0, cus = 0, per_cu = 0;
        hipGetDevice(&dev); hipDeviceGetAttribute(&cus, hipDeviceAttributeMultiprocessorCount, dev);
        if (hipFuncSetAttribute((const void*)hymba_fwd, hipFuncAttributeMaxDynamicSharedMemorySize, LDS_BYTES) != hipSuccess) { fprintf(stderr, "kernel_launch: hipFuncSetAttribute failed\n"); grid = -1; return; }
        hipOccupancyMaxActiveBlocksPerMultiprocessor(&per_cu, (const void*)hymba_fwd, 512, LDS_BYTES);
        if (per_cu < 1) per_cu = 1;
        (void)hipGetLastError();
        grid = cus * 1;
        if (grid > 256) grid = 256;
    }
    if (grid < 0) return;
    hipMemsetAsync((char*)d_ws + WS_CTL, 0, 16384, stream);
    Args a{};
    a.x = (const float*)d_in[0]; a.norm_gain = (const float*)d_in[1]; a.w_in = (const float*)d_in[2]; a.w_out = (const float*)d_in[3]; a.rel_bias = (const float*)d_in[4];
    a.qk_gain = (const float*)d_in[5]; a.diff_lambda = (const float*)d_in[6]; a.forget_bias = (const float*)d_in[7]; a.out_gain = (const float*)d_in[8]; a.rwkv_mu = (const float*)d_in[9];
    a.rwkv_w_up = (const float*)d_in[10]; a.rwkv_w0 = (const float*)d_in[11]; a.rwkv_a_up = (const float*)d_in[12]; a.rwkv_a0 = (const float*)d_in[13]; a.rwkv_kkr = (const float*)d_in[14];
    a.rwkv_ln_gain = (const float*)d_in[15]; a.rwkv_ln_bias = (const float*)d_in[16];
    a.out = (float*)d_out; a.ws = (unsigned char*)d_ws;
#if MK_PER_PHASE
    for (int ph = 0; ph < 11; ++ph) { a.ph_lo = ph; a.ph_hi = ph + 1; hipLaunchKernelGGL(hymba_fwd, dim3(grid), dim3(512), LDS_BYTES, stream, a); }
#else
    a.ph_lo = 0; a.ph_hi = 11;
    void* args[] = {&a};
    hipError_t e = hipLaunchCooperativeKernel((const void*)hymba_fwd, dim3(grid), dim3(512), args, LDS_BYTES, stream);
    if (e != hipSuccess) fprintf(stderr, "cooperative launch failed: %s (grid %d)\n", hipGetErrorString(e), grid);
#endif
}
```
